# Optimizing an MI355X kernel written in HIP

```python
import jax, jax.numpy as jnp
from jax import lax
import numpy as np

D_MODEL = 2048
BATCH = 2
SEQ = 16384
DEPTH = 2

GRID_W = 64
CTX_LEN = 256
MIX_WIDTH = D_MODEL
HGRN_WIDTH = MIX_WIDTH // 2
POOL_WIDTH = MIX_WIDTH - HGRN_WIDTH
HGRN_HEAD_DIM = 128
HGRN_HEADS = HGRN_WIDTH // HGRN_HEAD_DIM
HGRN_CHUNK = 64
POOL_WINDOWS = (2, 4, 8, 16)
POOL_GROUPS = len(POOL_WINDOWS)
POOL_GROUP_DIM = POOL_WIDTH // POOL_GROUPS
D_FF = 256 * ((8 * D_MODEL // 3 + 255) // 256)
N_MOD = 9
IN_WIDTH = 5 * HGRN_WIDTH + POOL_WIDTH
EPS = 1e-6
LOG_ZERO = -1e30

kernel_name = "hybrid_hgrn2_pool_macaron_dit"


def rms_norm(x, gain):
    xf = x.astype(jnp.float32)
    y = xf * lax.rsqrt(jnp.mean(xf * xf, axis=-1, keepdims=True) + EPS)
    return (y * gain.astype(jnp.float32)).astype(x.dtype)


def modulate(h, shift, scale):
    return h * (1 + scale) + shift


def swiglu(h, w_in, w_out):
    gate, up = jnp.split(h @ w_in, 2, axis=-1)
    return (jax.nn.silu(gate) * up) @ w_out


def ffn_sublayer(x, mod, j, gains, w_in, w_out):
    h = modulate(rms_norm(x, gains[2 * j]), mod[:, 3 * j, None, :], mod[:, 3 * j + 1, None, :])
    y = rms_norm(swiglu(h, w_in, w_out), gains[2 * j + 1])
    return x + 0.5 * mod[:, 3 * j + 2, None, :] * y


def gla_chunk_scan(q, k, v, log_f, s0):
    bsz, L, H, dk = q.shape
    dv = v.shape[-1]
    n = L // HGRN_CHUNK
    to_chunks = lambda a: jnp.moveaxis(a.reshape(bsz, n, HGRN_CHUNK, H, a.shape[-1]), 1, 0)
    mask = jnp.tril(jnp.ones((HGRN_CHUNK, HGRN_CHUNK), dtype=bool))

    def step(S, inp):
        qc, kc, vc, gc = inp
        b = jnp.cumsum(gc, axis=1)
        o_inter = jnp.einsum('bthk,bhkv->bthv', qc * jnp.exp(b), S)
        diff = b[:, :, None] - b[:, None, :]
        decay = jnp.where(mask[None, :, :, None, None], jnp.exp(jnp.minimum(diff, 0.0)), 0.0)
        attn = jnp.sum(qc[:, :, None] * kc[:, None] * decay, axis=-1)
        o_intra = jnp.einsum('btsh,bshv->bthv', attn, vc)
        b_end = b[:, -1]
        S_new = jnp.exp(b_end)[..., None] * S + jnp.einsum(
            'bshk,bshv->bhkv', kc * jnp.exp(b_end[:, None] - b), vc)
        return S_new, o_inter + o_intra

    s_final, o = lax.scan(step, s0, (to_chunks(q), to_chunks(k), to_chunks(v), to_chunks(log_f)))
    o = jnp.moveaxis(o, 0, 1).reshape(bsz, L, H, dv)
    return o, s_final


def hgrn2_direction(qh, vh, f_logit, lb, s0, reverse):
    bsz, L = f_logit.shape[:2]
    shp = (bsz, L, HGRN_HEADS, HGRN_HEAD_DIM)
    pos = lb > 0
    log_lb = jnp.where(pos, jnp.log(jnp.where(pos, lb, 1.0)), LOG_ZERO)
    log_f = jnp.logaddexp(jax.nn.log_sigmoid(f_logit),
                          log_lb + jax.nn.log_sigmoid(-f_logit)).reshape(shp)
    kh = ((1 - lb) * jax.nn.sigmoid(-f_logit)).reshape(shp)
    if reverse:
        qh, kh, vh, log_f = (jnp.flip(a, axis=1) for a in (qh, kh, vh, log_f))
    o, s = gla_chunk_scan(qh, kh, vh, log_f, s0)
    if reverse:
        o = jnp.flip(o, axis=1)
    return o, s


def hgrn2_mixer(q, f_fw, f_bw, iv, g, lb, gain, s0_fw, s0_bw):
    bsz, L, _ = q.shape
    shp = (bsz, L, HGRN_HEADS, HGRN_HEAD_DIM)
    qh = jax.nn.silu(q.astype(jnp.float32)).reshape(shp)
    vh = iv.astype(jnp.float32).reshape(shp)
    o_fw, s_fw = hgrn2_direction(qh, vh, f_fw.astype(jnp.float32), lb[0], s0_fw, False)
    o_bw, s_bw = hgrn2_direction(qh, vh, f_bw.astype(jnp.float32), lb[1], s0_bw, True)
    o = rms_norm(o_fw + o_bw, gain).reshape(bsz, L, HGRN_WIDTH)
    o = o * jax.nn.silu(g.astype(jnp.float32))
    return o.astype(q.dtype), s_fw, s_bw


def box_mean(v, w, axis):
    n = v.shape[axis]
    pad = [(0, 0)] * v.ndim
    pad[axis] = (1, 0)
    cs = jnp.pad(jnp.cumsum(v, axis=axis), pad)
    t = jnp.arange(n)
    lo = jnp.clip(t - w // 2, 0, n)
    hi = jnp.clip(t + w - w // 2, 0, n)
    s = jnp.take(cs, hi, axis=axis) - jnp.take(cs, lo, axis=axis)
    cnt_shape = [1] * v.ndim
    cnt_shape[axis] = n
    return s / (hi - lo).astype(v.dtype).reshape(cnt_shape)


def pool_mixer(p, rows, w_pool, b_pool, pool_scale):
    bsz, L, _ = p.shape
    groups = p.astype(jnp.float32).reshape(bsz, L, POOL_GROUPS, POOL_GROUP_DIM)
    outs = []
    for gi, w in enumerate(POOL_WINDOWS):
        v = groups[:, :, gi]
        if rows > 0:
            vg = v.reshape(bsz, rows, GRID_W, POOL_GROUP_DIM)
            m = box_mean(box_mean(vg, w, 1), w, 2).reshape(bsz, L, POOL_GROUP_DIM)
        else:
            m = box_mean(v, w, 1)
        outs.append(m - v)
    d = jnp.stack(outs, axis=2).astype(p.dtype)
    y = jnp.einsum('blgc,gcd->blgd', d, w_pool).reshape(bsz, L, POOL_WIDTH) + b_pool
    return y * pool_scale


def setup_inputs(seed: int = 0) -> dict:
    key = jax.random.key(seed)
    ks = jax.random.split(key, 16)
    f32 = jnp.float32
    nrm = lambda k, shp, s: jax.random.normal(k, shp, f32) * s
    return {
        "x": nrm(ks[0], (BATCH, SEQ, D_MODEL), 1.0),
        "c": nrm(ks[1], (BATCH, D_MODEL), 1.0),
        "ctx": nrm(ks[2], (BATCH, CTX_LEN, D_MODEL), 1.0),
        "c_ctx": nrm(ks[3], (D_MODEL,), 1.0),
        "w_ada": nrm(ks[4], (DEPTH, D_MODEL, N_MOD * D_MODEL), 0.5 * D_MODEL ** -0.5),
        "b_ada": nrm(ks[5], (DEPTH, N_MOD * D_MODEL), 0.02),
        "norm_gain": 1.0 + nrm(ks[6], (DEPTH, 6, D_MODEL), 0.05),
        "ffn_in": nrm(ks[7], (DEPTH, 2, D_MODEL, 2 * D_FF), D_MODEL ** -0.5),
        "ffn_out": nrm(ks[8], (DEPTH, 2, D_FF, D_MODEL), D_FF ** -0.5),
        "w_in": nrm(ks[9], (DEPTH, D_MODEL, IN_WIDTH), D_MODEL ** -0.5),
        "hgrn_lb": nrm(ks[10], (DEPTH, 2, HGRN_WIDTH), 0.5),
        "hgrn_gain": 1.0 + nrm(ks[11], (DEPTH, HGRN_HEAD_DIM), 0.05),
        "w_pool": nrm(ks[12], (DEPTH, POOL_GROUPS, POOL_GROUP_DIM, POOL_GROUP_DIM), POOL_GROUP_DIM ** -0.5),
        "b_pool": nrm(ks[13], (DEPTH, POOL_WIDTH), 0.02),
        "pool_scale": 1.0 + nrm(ks[14], (DEPTH, POOL_WIDTH), 0.1),
        "w_out": nrm(ks[15], (DEPTH, MIX_WIDTH, D_MODEL), MIX_WIDTH ** -0.5),
    }


def reference(x, c, ctx, c_ctx, w_ada, b_ada, norm_gain, ffn_in, ffn_out, w_in, hgrn_lb,
              hgrn_gain, w_pool, b_pool, pool_scale, w_out):
    bsz, seq = x.shape[0], x.shape[1]
    rows = seq // GRID_W
    split_at = [HGRN_WIDTH * k for k in range(1, 6)]
    lbp = jax.nn.softmax(hgrn_lb.astype(jnp.float32), axis=0)
    lower_bounds = jnp.cumsum(lbp, axis=0) - lbp[0]
    s0 = jnp.zeros((bsz, HGRN_HEADS, HGRN_HEAD_DIM, HGRN_HEAD_DIM), jnp.float32)
    for l in range(DEPTH):
        last = l == DEPTH - 1
        gains = norm_gain[l]
        mod_x = (jax.nn.silu(c) @ w_ada[l] + b_ada[l]).reshape(bsz, N_MOD, D_MODEL)
        mod_c = (jax.nn.silu(c_ctx)[None] @ w_ada[l] + b_ada[l]).reshape(1, N_MOD, D_MODEL)

        x = ffn_sublayer(x, mod_x, 0, gains, ffn_in[l, 0], ffn_out[l, 0])
        ctx = ffn_sublayer(ctx, mod_c, 0, gains, ffn_in[l, 0], ffn_out[l, 0])

        h_x = modulate(rms_norm(x, gains[2]), mod_x[:, 3, None, :], mod_x[:, 4, None, :])
        h_c = modulate(rms_norm(ctx, gains[2]), mod_c[:, 3, None, :], mod_c[:, 4, None, :])
        qx, ffx, fbx, ix, gx, px = jnp.split(h_x @ w_in[l], split_at, axis=-1)
        qc, ffc, fbc, ic, gc, pc = jnp.split(h_c @ w_in[l], split_at, axis=-1)
        o_c, s_fw, s_bw = hgrn2_mixer(qc, ffc, fbc, ic, gc, lower_bounds[l], hgrn_gain[l], s0, s0)
        o_x, _, _ = hgrn2_mixer(qx, ffx, fbx, ix, gx, lower_bounds[l], hgrn_gain[l], s_fw, s_bw)
        mix_x = jnp.concatenate(
            [o_x, pool_mixer(px, rows, w_pool[l], b_pool[l], pool_scale[l])], axis=-1) @ w_out[l]
        x = x + mod_x[:, 5, None, :] * rms_norm(mix_x, gains[3])
        if not last:
            mix_c = jnp.concatenate(
                [o_c, pool_mixer(pc, 0, w_pool[l], b_pool[l], pool_scale[l])], axis=-1) @ w_out[l]
            ctx = ctx + mod_c[:, 5, None, :] * rms_norm(mix_c, gains[3])
            ctx = ffn_sublayer(ctx, mod_c, 2, gains, ffn_in[l, 1], ffn_out[l, 1])

        x = ffn_sublayer(x, mod_x, 2, gains, ffn_in[l, 1], ffn_out[l, 1])
    return x
```

```cpp
#include <hip/hip_runtime.h>
#include <cstdio>
#include <cstdint>
namespace pg8 {
#define PG8_LAS __attribute__((address_space(3)))
typedef unsigned short bf16_t;
typedef short bf16x8 __attribute__((ext_vector_type(8)));
typedef float f32x4 __attribute__((ext_vector_type(4)));
typedef unsigned u32x4 __attribute__((ext_vector_type(4)));
constexpr int BM = 256, BK = 64, HALF = 128, HTB = HALF * BK * 2  , STAGE_BYTES = 8 * HTB, NXCD = 8, WGM = 4;

__host__ __device__ __forceinline__ int lds_byte(int r, int c) { const int st = (r >> 4) * 2 + (c >> 5), rr = r & 15, cc = c & 31, ob = rr * 64 + cc * 2; return st * 1024 + (ob ^ (((ob >> 9) & 1) << 5)); }
__host__ __device__ __forceinline__ void stage_rc(int b, int& R, int& C) { const int st = b / 1024, sb = b % 1024, swz = sb ^ (((sb >> 9) & 1) << 5); R = (st >> 1) * 16 + swz / 64; C = (st & 1) * 32 + (swz % 64) / 2; }
__host__ __device__ __forceinline__ int perm32(int rho) { const int n = rho >> 4, i = rho & 15; return 8 * (i >> 2) + 4 * n + (i & 3); }

struct Unit { int pm, pn, kt0, nkt; };
struct Gemm { const bf16_t* A; const bf16_t* Bt; int lda, ldb, K, a_pn_off; };

struct StaticOrder {
    int nM, nN, nwg, G, c, nkt, tail_pm0, tail_npm, nsplit;
    __host__ __device__ void init(int M, int N, int G_, int c_, int nkt_, int tail_npm_ = 0, int nsplit_ = 1) { nM = M / BM; nN = N / BM; nwg = nM * nN; G = G_; c = c_; nkt = nkt_; tail_pm0 = nM; tail_npm = tail_npm_; nsplit = nsplit_; }
    __host__ __device__ bool next(int i, Unit& u) const {
        const long L = (long)i * G + c; int pm, pn, kt0 = 0, nk = nkt;
        if (L >= nwg) { int t = (int)(L - nwg); if (t >= tail_npm * nN * nsplit) return false; pn = t % nN; t /= nN; pm = tail_pm0 + t % tail_npm; nk = nkt / nsplit; kt0 = (t / tail_npm) * nk; }
        else {
            int wgid = (int)L; { const int q = nwg / NXCD, r = nwg % NXCD, xcd = wgid % NXCD, off = wgid / NXCD; wgid = (xcd < r ? xcd * (q + 1) : r * (q + 1) + (xcd - r) * q) + off; }
            const int nig = WGM * nN, gid = wgid / nig, fm = gid * WGM, gsz = (nM - fm) < WGM ? (nM - fm) : WGM;
            pm = fm + ((wgid % nig) % gsz); pn = (wgid % nig) / gsz; }
        u.pm = pm; u.pn = pn; u.kt0 = kt0; u.nkt = nk; return true;
    }
    __device__ __forceinline__ void a_ready(const Unit&) const {}
    __device__ __forceinline__ void done(const Unit&) const {}
};


typedef float f32x2 __attribute__((ext_vector_type(2)));
typedef __bf16 bf16n2e_t __attribute__((ext_vector_type(2)));
__device__ __forceinline__ unsigned cvt_pk_bf16(float lo, float hi) { const f32x2 v = {lo, hi}; return __builtin_bit_cast(unsigned, __builtin_convertvector(v, bf16n2e_t)); }

struct EpiBf16 {
    static constexpr bool PERM = true, AFTER_DRAIN = false;
    bf16_t* O; int ldc; int col_off; const float* bias; const float* scale; float* part; int part_row0; size_t part_stride; unsigned silu_tiles;
    __device__ __forceinline__ void operator()(const f32x4 (&acc)[2][2][4][2], const Unit& u, int wr, int wc, int fr, int fq) const {
        const int row0 = u.pm * BM + wr * 64 + fr; const int bcol0 = u.pn * BM + wc * 32 + 8 * fq, col0 = col_off + bcol0;
        if (part != nullptr && row0 >= part_row0) {
            float* pb = part + (size_t)(u.kt0 / u.nkt) * part_stride + (size_t)(row0 - part_row0) * ldc + bcol0;
#pragma unroll
            for (int bj = 0; bj < 2; ++bj)
#pragma unroll
                for (int ai = 0; ai < 2; ++ai)
#pragma unroll
                    for (int m = 0; m < 4; ++m) { float* rp = pb + (size_t)(ai * HALF + m * 16) * ldc + bj * HALF; *(f32x4*)rp = acc[ai][bj][m][0]; *(f32x4*)(rp + 4) = acc[ai][bj][m][1]; }
            return;
        }
#pragma unroll
        for (int bj = 0; bj < 2; ++bj) {
            f32x4 b0 = {0.f, 0.f, 0.f, 0.f}, b1 = b0, s0 = {1.f, 1.f, 1.f, 1.f}, s1 = s0;
            if (bias) { b0 = *(const f32x4*)(bias + bcol0 + bj * HALF); b1 = *(const f32x4*)(bias + bcol0 + bj * HALF + 4); }
            if (scale) { s0 = *(const f32x4*)(scale + bcol0 + bj * HALF); s1 = *(const f32x4*)(scale + bcol0 + bj * HALF + 4); }
#pragma unroll
            for (int ai = 0; ai < 2; ++ai)
#pragma unroll
                for (int m = 0; m < 4; ++m) { bf16_t* rowp = O + (size_t)(row0 + ai * HALF + m * 16) * ldc + col0 + bj * HALF;
                    f32x4 v0 = (acc[ai][bj][m][0] + b0) * s0, v1 = (acc[ai][bj][m][1] + b1) * s1;
                    if ((silu_tiles >> u.pn) & 1u) {
#pragma unroll
                        for (int j = 0; j < 4; ++j) { v0[j] *= __builtin_amdgcn_rcpf(1.0f + __builtin_amdgcn_exp2f(v0[j] * -1.44269504089f)); v1[j] *= __builtin_amdgcn_rcpf(1.0f + __builtin_amdgcn_exp2f(v1[j] * -1.44269504089f)); } }
                    u32x4 w; w.x = cvt_pk_bf16(v0[0], v0[1]); w.y = cvt_pk_bf16(v0[2], v0[3]); w.z = cvt_pk_bf16(v1[0], v1[1]); w.w = cvt_pk_bf16(v1[2], v1[3]);
                    *(u32x4*)rowp = w; }
        }
    }
};
struct EpiSwiglu {
    static constexpr bool PERM = true, AFTER_DRAIN = false;
    bf16_t* H; int ldc;
    __device__ __forceinline__ void operator()(const f32x4 (&acc)[2][2][4][2], const Unit& u, int wr, int wc, int fr, int fq) const {
        const int row0 = u.pm * BM + wr * 64 + fr, col0 = u.pn * HALF + wc * 32 + 8 * fq;
#pragma unroll
        for (int ai = 0; ai < 2; ++ai)
#pragma unroll
            for (int m = 0; m < 4; ++m) { bf16_t* rowp = H + (size_t)(row0 + ai * HALF + m * 16) * ldc + col0;
                f32x4 o[2];
#pragma unroll
                for (int n = 0; n < 2; ++n) { const f32x4 gt = acc[ai][0][m][n], up = acc[ai][1][m][n];
#pragma unroll
                    for (int j = 0; j < 4; ++j) { const float e = __builtin_amdgcn_exp2f(gt[j] * -1.44269504089f); o[n][j] = gt[j] * __builtin_amdgcn_rcpf(1.0f + e) * up[j]; } }
                u32x4 w; w.x = cvt_pk_bf16(o[0][0], o[0][1]); w.y = cvt_pk_bf16(o[0][2], o[0][3]); w.z = cvt_pk_bf16(o[1][0], o[1][1]); w.w = cvt_pk_bf16(o[1][2], o[1][3]);
                __builtin_nontemporal_store(w, (u32x4*)rowp); }
    }
};

template <class Epi, class Sched, bool ALIGN_EPI = false, bool SP2 = false>
__device__ __forceinline__ void gemm_phase(PG8_LAS unsigned char* lds, const Gemm g, const Sched& S, const Epi& E) {
    int tid_ = threadIdx.x; asm volatile("" : "+v"(tid_));
    const int tid = tid_, wid = __builtin_amdgcn_readfirstlane(tid >> 6), lane = tid & 63, wr = wid >> 2, wc = wid & 3, fr = lane & 15, fq = lane >> 4;
    const int lda = g.lda, ldb = g.ldb;
    unsigned voffA[2], voffB[2];
#pragma unroll
    for (int i = 0; i < 2; ++i) { int R, C; stage_rc(tid * 16 + i * 8192, R, C); const int Rb = Epi::PERM ? ((R & ~31) + perm32(R & 31)) : R;
        voffA[i] = (unsigned)(R * lda + C) * 2u; voffB[i] = (unsigned)(Rb * ldb + C) * 2u; }
    const size_t kstep = (size_t)(BK * 2);
    const size_t hstepA = (size_t)HALF * lda * 2, hstepB = (size_t)HALF * ldb * 2;
    const size_t tstepA = 2 * hstepA, tstepB = 2 * hstepB; const size_t pnoffA = (size_t)g.a_pn_off * 2;
    const unsigned ldsw = (unsigned)wid * 1024u;
    const int aoff = lds_byte(wr * 64 + fr, fq * 8), boff = lds_byte(wc * 32 + fr, fq * 8);
#define PG8_SA(b, h) (((b) * 2 + (h)) * HTB)
#define PG8_SB(b, h) ((4 + (b) * 2 + (h)) * HTB)
#define PG8_STAGE(bufoff, gbase, voff) do { _Pragma("unroll") for (int _i = 0; _i < 2; ++_i) \
        __builtin_amdgcn_global_load_lds((const unsigned*)((const char*)(gbase) + (voff)[_i]), (PG8_LAS unsigned*)(lds + (bufoff) + ldsw + _i * 8192), 16, 0, 0); } while (0)
#define PG8_LDA(dst, b, h) do { _Pragma("unroll") for (int m = 0; m < 4; ++m) _Pragma("unroll") for (int k = 0; k < 2; ++k) dst[m][k] = *(const PG8_LAS bf16x8*)(lds + PG8_SA(b, h) + aoff + m * 2048 + k * 1024); } while (0)
#define PG8_LDB(dst, b, h) do { _Pragma("unroll") for (int n = 0; n < 2; ++n) _Pragma("unroll") for (int k = 0; k < 2; ++k) dst[n][k] = *(const PG8_LAS bf16x8*)(lds + PG8_SB(b, h) + boff + n * 2048 + k * 1024); } while (0)
#define PG8_MMA(ai, bj, At, Bt) do { __builtin_amdgcn_s_setprio(1); _Pragma("unroll") for (int m = 0; m < 4; ++m) _Pragma("unroll") for (int n = 0; n < 2; ++n) _Pragma("unroll") for (int k = 0; k < 2; ++k) \
        acc[ai][bj][m][n] = __builtin_amdgcn_mfma_f32_16x16x32_bf16(Bt[n][k], At[m][k], acc[ai][bj][m][n], 0, 0, 0); __builtin_amdgcn_s_setprio(0); } while (0)
#define PG8_WAIT_V(n) asm volatile("s_waitcnt vmcnt(" #n ")" ::: "memory")
#define PG8_WAIT_L(n) asm volatile("s_waitcnt lgkmcnt(" #n ")" ::: "memory")
#define PG8_BAR __builtin_amdgcn_s_barrier()
#define PG8_SCHED __builtin_amdgcn_sched_barrier(0)
    Unit cur, nxt; int ui = 0;
    if (!S.next(0, cur)) return;
    f32x4 acc[2][2][4][2];
#pragma unroll
    for (int a = 0; a < 2; ++a)
#pragma unroll
        for (int b = 0; b < 2; ++b)
#pragma unroll
            for (int m = 0; m < 4; ++m)
#pragma unroll
                for (int n = 0; n < 2; ++n) acc[a][b][m][n] = (f32x4){0.f, 0.f, 0.f, 0.f};
    bf16x8 At[4][2], B0[2][2], B1[2][2];
    const char* cA = (const char*)g.A + (size_t)cur.pm * tstepA + (size_t)cur.pn * pnoffA + (size_t)cur.kt0 * kstep; const char* cB = (const char*)g.Bt + (size_t)cur.pn * tstepB + (size_t)cur.kt0 * kstep;
    S.a_ready(cur);
    if constexpr (SP2) {
        PG8_STAGE(PG8_SB(0, 0), cB, voffB); PG8_STAGE(PG8_SB(0, 1), cB + hstepB, voffB); PG8_STAGE(PG8_SA(0, 0), cA, voffA); PG8_STAGE(PG8_SA(0, 1), cA + hstepA, voffA);
        if (wr == 1) PG8_BAR;
        PG8_WAIT_V(2); PG8_BAR;
        PG8_STAGE(PG8_SB(1, 0), cB + kstep, voffB); PG8_STAGE(PG8_SA(1, 0), cA + kstep, voffA); PG8_STAGE(PG8_SB(1, 1), cB + hstepB + kstep, voffB);
        PG8_WAIT_V(6); PG8_BAR;
    } else {
        PG8_STAGE(PG8_SB(0, 0), cB, voffB); PG8_STAGE(PG8_SA(0, 0), cA, voffA); PG8_STAGE(PG8_SB(0, 1), cB + hstepB, voffB); PG8_STAGE(PG8_SA(0, 1), cA + hstepA, voffA);
        if (wr == 1) PG8_BAR;
        PG8_WAIT_V(4); PG8_BAR;
        PG8_STAGE(PG8_SB(1, 0), cB + kstep, voffB); PG8_STAGE(PG8_SA(1, 0), cA + kstep, voffA); PG8_STAGE(PG8_SB(1, 1), cB + hstepB + kstep, voffB);
        PG8_WAIT_V(6); PG8_BAR;
    }
    for (;;) {
        const bool has_next = S.next(ui + 1, nxt);
        const char* nA = has_next ? (const char*)g.A + (size_t)nxt.pm * tstepA + (size_t)nxt.pn * pnoffA + (size_t)nxt.kt0 * kstep : cA; const char* nB = has_next ? (const char*)g.Bt + (size_t)nxt.pn * tstepB + (size_t)nxt.kt0 * kstep : cB;
        const int nt = cur.nkt;
        for (int t = 0; t < nt; t += 2) {
            const bool last = (t == nt - 2);
            const char* a1 = cA + (size_t)(t + 1) * kstep;
            const char* a2 = last ? nA : cA + (size_t)(t + 2) * kstep; const char* b2 = last ? nB : cB + (size_t)(t + 2) * kstep;
            const char* a3 = a2 + kstep; const char* b3 = b2 + kstep;
            if (last && has_next) S.a_ready(nxt);
            if constexpr (SP2) {
            PG8_LDB(B0, 0, 0); PG8_LDB(B1, 0, 1); PG8_SCHED; PG8_LDA(At, 0, 0); PG8_STAGE(PG8_SA(1, 1), a1 + hstepA, voffA);
            PG8_WAIT_V(8); PG8_WAIT_L(0); PG8_BAR; PG8_MMA(0, 0, At, B0); PG8_MMA(0, 1, At, B1); PG8_BAR; PG8_SCHED;
            PG8_LDA(At, 0, 1); PG8_STAGE(PG8_SB(0, 0), b2, voffB); PG8_STAGE(PG8_SB(0, 1), b2 + hstepB, voffB); PG8_STAGE(PG8_SA(0, 0), a2, voffA);
            PG8_WAIT_V(8); PG8_WAIT_L(0); PG8_BAR; PG8_MMA(1, 0, At, B0); PG8_MMA(1, 1, At, B1); PG8_BAR; PG8_SCHED;
            PG8_LDB(B0, 1, 0); PG8_LDB(B1, 1, 1); PG8_SCHED; PG8_LDA(At, 1, 0); PG8_STAGE(PG8_SA(0, 1), a2 + hstepA, voffA);
            PG8_WAIT_V(8); PG8_WAIT_L(0); PG8_BAR; PG8_MMA(0, 0, At, B0); PG8_MMA(0, 1, At, B1); PG8_BAR; PG8_SCHED;
            PG8_LDA(At, 1, 1); PG8_STAGE(PG8_SB(1, 0), b3, voffB); PG8_STAGE(PG8_SB(1, 1), b3 + hstepB, voffB); PG8_STAGE(PG8_SA(1, 0), a3, voffA);
            PG8_WAIT_V(8); PG8_WAIT_L(0); PG8_BAR; PG8_MMA(1, 0, At, B0); PG8_MMA(1, 1, At, B1); PG8_BAR; PG8_SCHED;
            } else {
            PG8_LDB(B0, 0, 0); PG8_SCHED; PG8_LDA(At, 0, 0); PG8_STAGE(PG8_SA(1, 1), a1 + hstepA, voffA);
            PG8_WAIT_L(8); PG8_BAR; PG8_WAIT_L(0); PG8_MMA(0, 0, At, B0); PG8_BAR; PG8_SCHED;
            PG8_LDB(B1, 0, 1); PG8_STAGE(PG8_SB(0, 0), b2, voffB);
            PG8_BAR; PG8_WAIT_L(0); PG8_MMA(0, 1, At, B1); PG8_BAR;
            PG8_LDA(At, 0, 1); PG8_STAGE(PG8_SA(0, 0), a2, voffA);
            PG8_BAR; PG8_WAIT_L(0); PG8_MMA(1, 0, At, B0); PG8_BAR; PG8_SCHED;
            PG8_STAGE(PG8_SB(0, 1), b2 + hstepB, voffB);
            PG8_WAIT_V(6); PG8_BAR; PG8_MMA(1, 1, At, B1); PG8_BAR;
            PG8_LDB(B0, 1, 0); PG8_SCHED; PG8_LDA(At, 1, 0); PG8_STAGE(PG8_SA(0, 1), a2 + hstepA, voffA);
            PG8_WAIT_L(8); PG8_BAR; PG8_WAIT_L(0); PG8_MMA(0, 0, At, B0); PG8_BAR; PG8_SCHED;
            PG8_LDB(B1, 1, 1); PG8_STAGE(PG8_SB(1, 0), b3, voffB);
            PG8_BAR; PG8_WAIT_L(0); PG8_MMA(0, 1, At, B1); PG8_BAR;
            PG8_LDA(At, 1, 1); PG8_STAGE(PG8_SA(1, 0), a3, voffA);
            PG8_BAR; PG8_WAIT_L(0); PG8_MMA(1, 0, At, B0); PG8_BAR; PG8_SCHED;
            PG8_STAGE(PG8_SB(1, 1), b3 + hstepB, voffB);
            PG8_WAIT_V(6); PG8_BAR; PG8_MMA(1, 1, At, B1); PG8_BAR;
            }
        }
        if constexpr (ALIGN_EPI) { if (wr == 0) PG8_BAR; }
        if constexpr (!Epi::AFTER_DRAIN) { E(acc, cur, wr, wc, fr, fq); S.done(cur); }
        if (!has_next) break;
#pragma unroll
        for (int a = 0; a < 2; ++a)
#pragma unroll
            for (int b = 0; b < 2; ++b)
#pragma unroll
                for (int m = 0; m < 4; ++m)
#pragma unroll
                    for (int n = 0; n < 2; ++n) acc[a][b][m][n] = (f32x4){0.f, 0.f, 0.f, 0.f};
        cur = nxt; cA = nA; cB = nB; ++ui;
        if constexpr (ALIGN_EPI) { if (wr == 1) PG8_BAR; }
    }
    PG8_WAIT_V(0);
    if constexpr (!ALIGN_EPI) { if (wr == 0) PG8_BAR; }
    PG8_BAR;
    if constexpr (Epi::AFTER_DRAIN) { E.fused(acc, cur, wr, wc, fr, fq, lds, wid, lane); S.done(cur); }
#undef PG8_SA
#undef PG8_SB
#undef PG8_STAGE
#undef PG8_LDA
#undef PG8_LDB
#undef PG8_MMA
#undef PG8_WAIT_V
#undef PG8_WAIT_L
#undef PG8_BAR
#undef PG8_SCHED
}
}

constexpr int D = 2048, NB = 2, SEQ = 16384, DEPTH = 2, GRID_W = 64, GRID_R = 256, CTXL = 256;
constexpr int HW = 1024, PW = 1024, HD = 128, NH = 8, DFF = 5632, NMOD = 9, INW = 6144;
constexpr int ML = NB * SEQ, MC = NB * CTXL, M = ML + MC;
constexpr int NSC = 33, SCT = 512;
constexpr float EPS = 1e-6f;
constexpr int NWAVES = 8, NTHR = 512;

constexpr size_t MiB = 1u << 20;
constexpr size_t WS_CTL = 0, ZERO_BYTES = 1 * MiB;
constexpr size_t WS_MOD = 2 * MiB + 65536;
constexpr size_t WS_LBV = 2 * MiB, WS_CTXS = 3 * MiB;
constexpr size_t WS_W1T = 8 * MiB, W1T_SZ = (size_t)2 * DFF * D * 2;
constexpr size_t WS_W2T = WS_W1T + 4 * W1T_SZ, W2T_SZ = (size_t)D * DFF * 2;
constexpr size_t WS_WINT = WS_W2T + 4 * W2T_SZ, WINT_SZ = (size_t)INW * D * 2;
constexpr size_t WS_WOT = WS_WINT + 2 * WINT_SZ, WOT_SZ = (size_t)D * D * 2;
constexpr size_t WS_WPT = WS_WOT + 2 * WOT_SZ, WPT_SZ = (size_t)PW * 256 * 2;
constexpr size_t WS_ABUF = 338 * MiB;
constexpr size_t WS_MIX = 468 * MiB;
constexpr size_t WS_HBUF = 598 * MiB;
constexpr size_t WS_YBUF = 988 * MiB;
constexpr size_t WS_HST = WS_YBUF + 65 * MiB;
constexpr size_t WS_XS = 1118 * MiB;
constexpr size_t WS_HSTC = 1374 * MiB;
constexpr size_t WS_PD = 1376 * MiB;
constexpr size_t WS_YP = 1377 * MiB;
constexpr size_t WS_END = 1393 * MiB;
static_assert(WS_WPT + 2 * WPT_SZ <= WS_ABUF && WS_ABUF + (size_t)M * D * 2 <= WS_MIX && WS_HBUF + (size_t)M * INW * 2 <= WS_YBUF && WS_YBUF + (size_t)M * D * 2 <= WS_XS, "ws map");
static_assert(WS_HST + (size_t)16 * 2 * 32 * 128 * 128 * 4 <= WS_XS && WS_XS + (size_t)ML * D * 4 <= WS_HSTC, "ws map 2");
constexpr int CW_TMO = 0, CW_BAR = 4096;

constexpr int RING_BYTES = 131072, LDSCTL_OFF = RING_BYTES, MISC_OFF = LDSCTL_OFF + 320, LDS_BYTES = 147456;

#define GAS __attribute__((address_space(1)))
#define LAS __attribute__((address_space(3)))
typedef unsigned short bf16;
typedef unsigned v4u __attribute__((ext_vector_type(4)));
typedef unsigned v2u __attribute__((ext_vector_type(2)));
typedef float f32x4 __attribute__((ext_vector_type(4)));
typedef float f32x2 __attribute__((ext_vector_type(2)));
typedef GAS unsigned gu32;
#define RLX_AGENT __ATOMIC_RELAXED, __HIP_MEMORY_SCOPE_AGENT
#define LDS_WAIT() asm volatile("s_waitcnt lgkmcnt(0)" ::: "memory")
#define VM_WAIT() asm volatile("s_waitcnt vmcnt(0)" ::: "memory")
__device__ __forceinline__ unsigned f2bf(float f) { unsigned u = __builtin_bit_cast(unsigned, f); return (u + 0x7fffu + ((u >> 16) & 1u)) >> 16; }
__device__ __forceinline__ unsigned pk2(float lo, float hi) { return f2bf(lo) | (f2bf(hi) << 16); }
__device__ __forceinline__ float bflo(unsigned w) { return __builtin_bit_cast(float, w << 16); }
__device__ __forceinline__ float bfhi(unsigned w) { return __builtin_bit_cast(float, w & 0xffff0000u); }
__device__ __forceinline__ float sigmoidf_(float z) { return __builtin_amdgcn_rcpf(1.0f + __builtin_amdgcn_exp2f(z * -1.44269504089f)); }
template <int CTRL> __device__ __forceinline__ float dpp_f(float v) { return __builtin_bit_cast(float, __builtin_amdgcn_update_dpp(0, __builtin_bit_cast(int, v), CTRL, 0xF, 0xF, true)); }
__device__ __forceinline__ float wave_sum(float v) {
    v += dpp_f<0xB1>(v);
    v += dpp_f<0x4E>(v);
    v += dpp_f<0x141>(v);
    v += dpp_f<0x140>(v);
    const float r0 = __builtin_bit_cast(float, __builtin_amdgcn_readlane(__builtin_bit_cast(int, v), 0)), r1 = __builtin_bit_cast(float, __builtin_amdgcn_readlane(__builtin_bit_cast(int, v), 16));
    const float r2 = __builtin_bit_cast(float, __builtin_amdgcn_readlane(__builtin_bit_cast(int, v), 32)), r3 = __builtin_bit_cast(float, __builtin_amdgcn_readlane(__builtin_bit_cast(int, v), 48));
    return (r0 + r1) + (r2 + r3);
}

#define XB_TMO      128
#define XB_XCNT(j)  (256  + 64 * (j))
#define XB_XSUB(j)  (1280 + 64 * (j))
#define XB_XGEN(j)  (2304 + 64 * (j))
#define XB_TOP      3328
#define XB_TOPGEN   3392
#define XCD_BAR_WORDS 3456
#define XB_SPIN_CAP (1u << 18)

__device__ __forceinline__ unsigned xb_ld(unsigned* p)              { return __hip_atomic_load(p, __ATOMIC_RELAXED, __HIP_MEMORY_SCOPE_AGENT); }
__device__ __forceinline__ unsigned xb_add(unsigned* p, unsigned v) { return __hip_atomic_fetch_add(p, v, __ATOMIC_RELAXED, __HIP_MEMORY_SCOPE_AGENT); }
__device__ __forceinline__ unsigned xb_xcc_id() { return (unsigned)__builtin_amdgcn_s_getreg((3 << 11) | 20) & 0xFu; }
#define XB_SPIN(cond, bar) do { unsigned _sp = 0; while (cond) { __builtin_amdgcn_s_sleep(1); \
    if ((++_sp & 255u) == 0u) { if (xb_ld(&(bar)[XB_TMO])) break; if (_sp > XB_SPIN_CAP) { atomicAdd(&(bar)[XB_TMO], 1u); break; } } } } while (0)

struct XcdBarrier {
    unsigned* bar; unsigned x;
    volatile LAS unsigned* st;
};

__device__ __forceinline__ XcdBarrier xcd_barrier_post(unsigned* bar, volatile LAS unsigned* st) {
    XcdBarrier b; b.bar = bar; b.x = xb_xcc_id(); b.st = st;
    if (threadIdx.x == 0) (void)xb_add(&bar[XB_XCNT(b.x)], 1u);
    return b;
}
__device__ __forceinline__ void xcd_barrier_complete(unsigned* bar, unsigned x, unsigned& nloc, unsigned& nx) {
    const unsigned G = gridDim.x * gridDim.y * gridDim.z;
    unsigned sum, cnt, mine, sp = 0u;
    for (;;) {
        sum = 0u; cnt = 0u; mine = 0u;
#pragma unroll
        for (unsigned j = 0; j < 16; ++j) { const unsigned c = xb_ld(&bar[XB_XCNT(j)]); sum += c; cnt += (c > 0u) ? 1u : 0u; mine = (j == x) ? c : mine; }
        if (sum == G) break;
        __builtin_amdgcn_s_sleep(1);
        if ((++sp & 255u) == 0u) { if (xb_ld(&bar[XB_TMO])) break; if (sp > XB_SPIN_CAP) { atomicAdd(&bar[XB_TMO], 1u); break; } }
    }
    nloc = mine > 0u ? mine : 1u; nx = cnt > 0u ? cnt : 1u;
}

__device__ __forceinline__ void xcd_barrier(const XcdBarrier& b) {
    asm volatile("s_waitcnt vmcnt(0)" ::: "memory");
    __syncthreads();
    if (threadIdx.x == 0) {
        unsigned* bar = b.bar;
        __builtin_amdgcn_s_waitcnt(0);
        unsigned nloc = b.st[0], nx = b.st[1];
        if (nloc == 0u) { xcd_barrier_complete(bar, b.x, nloc, nx); b.st[0] = nloc; b.st[1] = nx; }
        const unsigned old = xb_add(&bar[XB_XSUB(b.x)], 1u);
        const unsigned gen = old / nloc;
        if (old + 1u == (gen + 1u) * nloc) {
            __builtin_amdgcn_fence(__ATOMIC_RELEASE, "agent");
            asm volatile("s_waitcnt vmcnt(0)" ::: "memory");
            const unsigned og = xb_add(&bar[XB_TOP], 1u);
            const unsigned tg = og / nx;
            if (og + 1u == (tg + 1u) * nx) xb_add(&bar[XB_TOPGEN], 1u);
            else XB_SPIN(xb_ld(&bar[XB_TOPGEN]) == tg, bar);
            __builtin_amdgcn_fence(__ATOMIC_ACQUIRE, "agent");
            xb_add(&bar[XB_XGEN(b.x)], 1u);
            asm volatile("s_waitcnt vmcnt(0)" ::: "memory");
        } else {
            XB_SPIN(xb_ld(&bar[XB_XGEN(b.x)]) == gen, bar);
            __builtin_amdgcn_fence(__ATOMIC_ACQUIRE, "agent");
            asm volatile("s_waitcnt vmcnt(0)" ::: "memory");
        }
    }
    __syncthreads();
}


struct Frame {
    LAS unsigned char* lds;
    int tid, lane, wave, vcu, G;
};

__device__ __forceinline__ void transpose_load(const float* W, int N, int k0, int n0, int lane, float (&r)[32]) {
#pragma unroll
    for (int i = 0; i < 32; ++i) { const int kk = 2 * i + (lane >> 5); r[i] = __builtin_nontemporal_load(W + (size_t)(k0 + kk) * N + n0 + (lane & 31)); }
}
__device__ __forceinline__ void transpose_store(const float (&r)[32], bf16* WT, int ldt, int k0, int drow0, LAS float* scr, int lane) {
#pragma unroll
    for (int i = 0; i < 32; ++i) { const int kk = 2 * i + (lane >> 5); scr[kk * 33 + (lane & 31)] = r[i]; }
    LDS_WAIT(); asm volatile("" ::: "memory");
    const int c = lane & 7;
#pragma unroll
    for (int j = 0; j < 4; ++j) { const int n = (lane >> 3) + 8 * j; const LAS float* s = scr + (8 * c) * 33 + n;
        v4u o; o.x = pk2(s[0 * 33], s[1 * 33]); o.y = pk2(s[2 * 33], s[3 * 33]); o.z = pk2(s[4 * 33], s[5 * 33]); o.w = pk2(s[6 * 33], s[7 * 33]);
        *(GAS v4u*)(WT + (size_t)(drow0 + n) * ldt + k0 + 8 * c) = o; }
    LDS_WAIT(); asm volatile("" ::: "memory");
}
__device__ __forceinline__ void transpose_decode(const float* const* in, unsigned char* ws, int it, const float*& W, int& N, bf16*& WT, int& ldt, int& k0, int& n0, int& drow0) {
    constexpr int I1 = (D / 64) * (2 * DFF / 32), I2 = (DFF / 64) * (D / 32), IIN = (D / 64) * (INW / 32), IOUT = (D / 64) * (D / 32), IP = (256 / 64) * (256 / 32);
    constexpr int IL = 2 * I1 + 2 * I2 + IIN + IOUT + 4 * IP;
    const int l = it / IL; int r = it % IL;
    if (r < 2 * I1) { const int j = r / I1; r %= I1; const int nblk = 2 * DFF / 32, kb = r / nblk, nb = r % nblk; n0 = nb * 32; k0 = kb * 64;
        drow0 = n0 < DFF ? 256 * (n0 / 128) + (n0 % 128) : 256 * ((n0 - DFF) / 128) + 128 + ((n0 - DFF) % 128);
        W = in[7] + (size_t)(l * 2 + j) * D * 2 * DFF; N = 2 * DFF; WT = (bf16*)(ws + WS_W1T + (size_t)(l * 2 + j) * W1T_SZ); ldt = D; return; }
    r -= 2 * I1;
    if (r < 2 * I2) { const int j = r / I2; r %= I2; const int nblk = D / 32, kb = r / nblk, nb = r % nblk; n0 = nb * 32; k0 = kb * 64; drow0 = n0;
        W = in[8] + (size_t)(l * 2 + j) * DFF * D; N = D; WT = (bf16*)(ws + WS_W2T + (size_t)(l * 2 + j) * W2T_SZ); ldt = DFF; return; }
    r -= 2 * I2;
    if (r < IIN) { const int nblk = INW / 32, kb = r / nblk, nb = r % nblk; n0 = nb * 32; k0 = kb * 64; drow0 = n0;
        W = in[9] + (size_t)l * D * INW; N = INW; WT = (bf16*)(ws + WS_WINT + (size_t)l * WINT_SZ); ldt = D; return; }
    r -= IIN;
    if (r < IOUT) { const int nblk = D / 32, kb = r / nblk, nb = r % nblk; n0 = nb * 32; k0 = kb * 64; drow0 = n0;
        W = in[15] + (size_t)l * D * D; N = D; WT = (bf16*)(ws + WS_WOT + (size_t)l * WOT_SZ); ldt = D; return; }
    r -= IOUT;
    { const int g = r / IP; r %= IP; const int nblk = 256 / 32, kb = r / nblk, nb = r % nblk; n0 = nb * 32; k0 = kb * 64; drow0 = g * 256 + n0;
        W = in[12] + (size_t)(l * 4 + g) * 256 * 256; N = 256; WT = (bf16*)(ws + WS_WPT + (size_t)l * WPT_SZ); ldt = 256; }
}
__device__ __forceinline__ void weight_copy(const Frame& F, const float* const* in, unsigned char* ws, int it0, int it1, int gw, int NGW) {
    LAS float* scr = (LAS float*)(F.lds + F.wave * 16384);
    int it = it0 + gw;
    if (it < it1) {
        const float* W; bf16* WT; int N, ldt, k0, n0, drow0; float r[32];
        transpose_decode(in, ws, it, W, N, WT, ldt, k0, n0, drow0); transpose_load(W, N, k0, n0, F.lane, r);
        for (;;) {
            const int itn = it + NGW; const bool more = itn < it1;
            const float* Wn = W; bf16* WTn = WT; int Nn = N, ldtn = ldt, k0n = k0, n0n = n0, drow0n = drow0; float rn[32];
            if (more) { transpose_decode(in, ws, itn, Wn, Nn, WTn, ldtn, k0n, n0n, drow0n); transpose_load(Wn, Nn, k0n, n0n, F.lane, rn); }
            transpose_store(r, WT, ldt, k0, drow0, scr, F.lane);
            if (!more) break;
            it = itn; W = Wn; WT = WTn; N = Nn; ldt = ldtn; k0 = k0n; n0 = n0n; drow0 = drow0n;
#pragma unroll
            for (int i = 0; i < 32; ++i) r[i] = rn[i];
        }
    }
}
constexpr int WC_IL = 2 * (D / 64) * (2 * DFF / 32) + 2 * (DFF / 64) * (D / 32) + (D / 64) * (INW / 32) + (D / 64) * (D / 32) + 4 * (256 / 64) * (256 / 32);
__device__ __forceinline__ void p0_prologue(const Frame& F, const float* const* in, unsigned char* ws) {
    const float* c_in = in[1]; const float* cctx = in[3]; const float* w_ada = in[4]; const float* b_ada = in[5];
    float* MOD = (float*)(ws + WS_MOD);
    LAS float* sv = (LAS float*)F.lds;
    LAS f32x4* part = (LAS f32x4*)(F.lds + 32768);
    for (int i = F.tid; i < 3 * D; i += NTHR) { const int r = i / D, k = i % D; const float v = r < 2 ? c_in[r * D + k] : cctx[k]; sv[i] = v * sigmoidf_(v); }
    __syncthreads();
    {
        constexpr int NV4 = NMOD * D / 4;
        for (int wi = F.vcu; wi < DEPTH * NV4 / 64; wi += F.G) {
            const int cg = wi * 64 + F.lane, l = cg / NV4, n4 = cg % NV4, kc = F.wave;
            const float* w = w_ada + ((size_t)l * D + kc * 256) * (NMOD * D) + n4 * 4;
            f32x4 a0 = {0.f, 0.f, 0.f, 0.f}, a1 = a0, a2 = a0;
#pragma unroll 8
            for (int k = 0; k < 256; ++k) { const f32x4 wv = __builtin_nontemporal_load((const GAS f32x4*)(w + (size_t)k * (NMOD * D)));
                a0 += sv[kc * 256 + k] * wv; a1 += sv[D + kc * 256 + k] * wv; a2 += sv[2 * D + kc * 256 + k] * wv; }
            part[(F.wave * 3 + 0) * 64 + F.lane] = a0; part[(F.wave * 3 + 1) * 64 + F.lane] = a1; part[(F.wave * 3 + 2) * 64 + F.lane] = a2;
            __syncthreads();
            if (F.wave < 3) { const int r = F.wave; f32x4 s = *(const GAS f32x4*)(b_ada + (size_t)l * NMOD * D + n4 * 4);
#pragma unroll
                for (int w8 = 0; w8 < 8; ++w8) s += part[(w8 * 3 + r) * 64 + F.lane];
                *(GAS f32x4*)(MOD + ((size_t)l * 3 + r) * NMOD * D + n4 * 4) = s; }
            __syncthreads();
        }
        const int gtid = F.vcu * NTHR + F.tid;
        if (gtid < 2 * HW) { const float* lbin = in[10]; float* LBV = (float*)(ws + WS_LBV);
            float a[DEPTH], mx = -3.0e38f, s = 0.f;
#pragma unroll
            for (int l = 0; l < DEPTH; ++l) { a[l] = lbin[l * 2 * HW + gtid]; mx = fmaxf(mx, a[l]); }
#pragma unroll
            for (int l = 0; l < DEPTH; ++l) { a[l] = __expf(a[l] - mx); s += a[l]; }
            float cum = 0.f; const float p0 = a[0] / s;
#pragma unroll
            for (int l = 0; l < DEPTH; ++l) { cum += a[l] / s; LBV[l * 2 * HW + gtid] = cum - p0; } }
    }
    __syncthreads();
    weight_copy(F, in, ws, 0, F.G == 256 ? WC_IL : DEPTH * WC_IL, F.vcu * NWAVES + F.wave, F.G * NWAVES);
}

struct NormP {
    const void* xin_l; const void* xin_c; void* xout_l; void* xout_c; const bf16* Y; bf16* A;
    const float* modR; const float* gainsR;
    const float* modA; const float* gainsA;
    const float* YP;
    int gateIdx, gain1Idx, gain2Idx, shiftIdx, scaleIdx, coefHalf;
};
typedef __amdgpu_buffer_rsrc_t rsrc_t;
__device__ __forceinline__ rsrc_t mk_rsrc(const void* p, unsigned bytes) { return __builtin_amdgcn_make_buffer_rsrc((void*)p, 0, bytes, 0x00020000); }
__device__ __forceinline__ f32x4 bld4(rsrc_t r, int voff, int soff) { return __builtin_bit_cast(f32x4, __builtin_amdgcn_raw_buffer_load_b128(r, voff, soff, 0)); }
__device__ __forceinline__ v4u bld4u(rsrc_t r, int voff, int soff) { return __builtin_bit_cast(v4u, __builtin_amdgcn_raw_buffer_load_b128(r, voff, soff, 0)); }
__device__ __forceinline__ v2u bld2u(rsrc_t r, int voff, int soff) { return __builtin_bit_cast(v2u, __builtin_amdgcn_raw_buffer_load_b64(r, voff, soff, 0)); }
__device__ __forceinline__ void bst4(f32x4 v, rsrc_t r, int voff, int soff) { __builtin_amdgcn_raw_buffer_store_b128(__builtin_bit_cast(v4u, v), r, voff, soff, 0); }
__device__ __forceinline__ void bst4u(v4u v, rsrc_t r, int voff, int soff) { __builtin_amdgcn_raw_buffer_store_b128(v, r, voff, soff, 0); }
__device__ __forceinline__ void bst2u(v2u v, rsrc_t r, int voff, int soff) { __builtin_amdgcn_raw_buffer_store_b64(v, r, voff, soff, 0); }
template <bool HAS_Y, bool HAS_A, bool YSPLIT, bool XIN16, bool XOUT16>
__device__ __forceinline__ void norm_rows(const Frame& F, const NormP P, int row0, int nrows, int r) {
    f32x4 cA[8], cB[8], cC[8];
    if (HAS_Y) { const GAS f32x4* g = (const GAS f32x4*)(P.modR + (size_t)(r * NMOD + P.gateIdx) * D) + F.lane; const GAS f32x4* n = (const GAS f32x4*)(P.gainsR + (size_t)P.gain1Idx * D) + F.lane;
        const float coef = P.coefHalf ? 0.5f : 1.0f;
#pragma unroll
        for (int j = 0; j < 8; ++j) cA[j] = coef * g[64 * j] * n[64 * j]; }
    if (HAS_A) { const GAS f32x4* n = (const GAS f32x4*)(P.gainsA + (size_t)P.gain2Idx * D) + F.lane; const GAS f32x4* sc = (const GAS f32x4*)(P.modA + (size_t)(r * NMOD + P.scaleIdx) * D) + F.lane;
        const GAS f32x4* sh = (const GAS f32x4*)(P.modA + (size_t)(r * NMOD + P.shiftIdx) * D) + F.lane;
#pragma unroll
        for (int j = 0; j < 8; ++j) { cB[j] = n[64 * j] * (1.0f + sc[64 * j]); cC[j] = sh[64 * j]; } }
    constexpr bool PF = XIN16 && HAS_Y && !YSPLIT;
    v2u xq[8], yq[8];
    if (PF) { const bf16* xp = row0 < ML ? (const bf16*)P.xin_l + (size_t)row0 * D : (const bf16*)P.xin_c + (size_t)(row0 - ML) * D; const GAS v2u* xr = (const GAS v2u*)xp + F.lane; const GAS v2u* yr = (const GAS v2u*)(P.Y + (size_t)row0 * D) + F.lane;
#pragma unroll
        for (int j = 0; j < 8; ++j) { xq[j] = __builtin_nontemporal_load(xr + 64 * j); yq[j] = __builtin_nontemporal_load(yr + 64 * j); } }
#pragma unroll 1
    for (int row = row0; row < row0 + nrows; ++row) {
        f32x4 x[8];
        if (PF) {
#pragma unroll
            for (int j = 0; j < 8; ++j) asm volatile("" : "+v"(xq[j].x), "+v"(xq[j].y), "+v"(yq[j].x), "+v"(yq[j].y));
#pragma unroll
            for (int j = 0; j < 8; ++j) x[j] = (f32x4){bflo(xq[j].x), bfhi(xq[j].x), bflo(xq[j].y), bfhi(xq[j].y)};
            if (row + 1 < row0 + nrows) { const int rn = row + 1; const bf16* xp = rn < ML ? (const bf16*)P.xin_l + (size_t)rn * D : (const bf16*)P.xin_c + (size_t)(rn - ML) * D; const GAS v2u* xr = (const GAS v2u*)xp + F.lane;
#pragma unroll
                for (int j = 0; j < 8; ++j) xq[j] = __builtin_nontemporal_load(xr + 64 * j); } }
        else if (XIN16) { const bf16* xp = row < ML ? (const bf16*)P.xin_l + (size_t)row * D : (const bf16*)P.xin_c + (size_t)(row - ML) * D; const GAS v2u* xr = (const GAS v2u*)xp + F.lane;
#pragma unroll
            for (int j = 0; j < 8; ++j) { const v2u w = __builtin_nontemporal_load(xr + 64 * j); x[j] = (f32x4){bflo(w.x), bfhi(w.x), bflo(w.y), bfhi(w.y)}; } }
        else { const float* xp = row < ML ? (const float*)P.xin_l + (size_t)row * D : (const float*)P.xin_c + (size_t)(row - ML) * D; const GAS f32x4* xr = (const GAS f32x4*)xp + F.lane;
#pragma unroll
            for (int j = 0; j < 8; ++j) x[j] = __builtin_nontemporal_load(xr + 64 * j); }
        if (HAS_Y && PF) {
            float ss = 0.f;
#pragma unroll
            for (int j = 0; j < 8; ++j) { const float a0 = bflo(yq[j].x), a1 = bfhi(yq[j].x), a2 = bflo(yq[j].y), a3 = bfhi(yq[j].y); ss += (a0 * a0 + a1 * a1) + (a2 * a2 + a3 * a3); }
            const float rinv = rsqrtf(wave_sum(ss) * (1.0f / D) + EPS);
#pragma unroll
            for (int j = 0; j < 8; ++j) { const f32x4 yv = {bflo(yq[j].x), bfhi(yq[j].x), bflo(yq[j].y), bfhi(yq[j].y)}; x[j] += cA[j] * (yv * rinv); }
            if (row + 1 < row0 + nrows) { const GAS v2u* yr = (const GAS v2u*)(P.Y + (size_t)(row + 1) * D) + F.lane;
#pragma unroll
                for (int j = 0; j < 8; ++j) yq[j] = __builtin_nontemporal_load(yr + 64 * j); }
            if (XOUT16) { bf16* xo = row < ML ? (bf16*)P.xout_l + (size_t)row * D : (bf16*)P.xout_c + (size_t)(row - ML) * D; GAS v2u* xw = (GAS v2u*)xo + F.lane;
#pragma unroll
                for (int j = 0; j < 8; ++j) { v2u w; w.x = pk2(x[j].x, x[j].y); w.y = pk2(x[j].z, x[j].w); __builtin_nontemporal_store(w, xw + 64 * j); x[j] = (f32x4){bflo(w.x), bfhi(w.x), bflo(w.y), bfhi(w.y)}; } }
            else { float* xo = row < ML ? (float*)P.xout_l + (size_t)row * D : (float*)P.xout_c + (size_t)(row - ML) * D; GAS f32x4* xw = (GAS f32x4*)xo + F.lane;
#pragma unroll
                for (int j = 0; j < 8; ++j) __builtin_nontemporal_store(x[j], xw + 64 * j); }
        }
        else if (HAS_Y) {
            f32x4 y[8]; float ss = 0.f;
            if (YSPLIT) { const GAS f32x4* yp = (const GAS f32x4*)(P.YP + (size_t)(row - ML) * D) + F.lane;
#pragma unroll
                for (int j = 0; j < 8; ++j) { y[j] = (yp[64 * j] + yp[64 * j + (size_t)MC * D / 4]) + (yp[64 * j + 2 * (size_t)MC * D / 4] + yp[64 * j + 3 * (size_t)MC * D / 4]); } }
            else { const GAS v2u* yr = (const GAS v2u*)(P.Y + (size_t)row * D) + F.lane;
#pragma unroll
                for (int j = 0; j < 8; ++j) { const v2u yw = __builtin_nontemporal_load(yr + 64 * j); y[j] = (f32x4){bflo(yw.x), bfhi(yw.x), bflo(yw.y), bfhi(yw.y)}; } }
#pragma unroll
            for (int j = 0; j < 8; ++j) ss += (y[j].x * y[j].x + y[j].y * y[j].y) + (y[j].z * y[j].z + y[j].w * y[j].w);
            const float rinv = rsqrtf(wave_sum(ss) * (1.0f / D) + EPS);
            if (XOUT16) { bf16* xo = row < ML ? (bf16*)P.xout_l + (size_t)row * D : (bf16*)P.xout_c + (size_t)(row - ML) * D; GAS v2u* xw = (GAS v2u*)xo + F.lane;
#pragma unroll
                for (int j = 0; j < 8; ++j) { x[j] += cA[j] * (y[j] * rinv); v2u w; w.x = pk2(x[j].x, x[j].y); w.y = pk2(x[j].z, x[j].w); __builtin_nontemporal_store(w, xw + 64 * j);
                    x[j] = (f32x4){bflo(w.x), bfhi(w.x), bflo(w.y), bfhi(w.y)}; } }
            else { float* xo = row < ML ? (float*)P.xout_l + (size_t)row * D : (float*)P.xout_c + (size_t)(row - ML) * D; GAS f32x4* xw = (GAS f32x4*)xo + F.lane;
#pragma unroll
                for (int j = 0; j < 8; ++j) { x[j] += cA[j] * (y[j] * rinv); __builtin_nontemporal_store(x[j], xw + 64 * j); } }
        }
        if (HAS_A) {
            float ss = 0.f;
#pragma unroll
            for (int j = 0; j < 8; ++j) ss += (x[j].x * x[j].x + x[j].y * x[j].y) + (x[j].z * x[j].z + x[j].w * x[j].w);
            const float rinv = rsqrtf(wave_sum(ss) * (1.0f / D) + EPS);
            GAS v2u* aw = (GAS v2u*)(P.A + (size_t)row * D) + F.lane;
#pragma unroll
            for (int j = 0; j < 8; ++j) { const f32x4 a = (x[j] * rinv) * cB[j] + cC[j]; v2u w; w.x = pk2(a.x, a.y); w.y = pk2(a.z, a.w); aw[64 * j] = w; }
        }
    }
}
template <bool HAS_Y, bool HAS_A, bool XIN16, bool XOUT16>
__device__ __forceinline__ void norm_phase(const Frame& F, const NormP P, bool do_ctx) {
    const int gw = F.vcu * NWAVES + F.wave, NGW = F.G * NWAVES;
    constexpr int RPW = 16;
    for (int it = gw; it < ML / RPW; it += NGW) norm_rows<HAS_Y, HAS_A, false, XIN16, XOUT16>(F, P, it * RPW, RPW, (it * RPW) / SEQ);
    if (do_ctx) for (int it = gw; it < MC; it += NGW) norm_rows<HAS_Y, HAS_A, HAS_Y, XIN16, XOUT16>(F, P, ML + it, 1, 2);
}

__device__ __forceinline__ float* hst_slot(unsigned char* ws, int bd, int sc) { return sc < 32 ? (float*)(ws + WS_HST) + ((size_t)bd * 32 + sc) * (HD * HD) : (float*)(ws + WS_HSTC) + (size_t)bd * (HD * HD); }
__device__ __forceinline__ int hst_k_of(int e) { return 16 * (e >> 11) + 4 * ((e >> 6) & 3) + (e & 3); }
constexpr int HC = 16, HROW = 272;
constexpr int HL_QH = 0, HL_KH = 16 * HROW, HL_KT = 32 * HROW, HL_VT = HL_KT + 4096, HL_P7 = HL_VT + 4096, HL_UP = HL_P7 + 512, HL_BUF = HL_UP + 512;
constexpr int HL_O = 2 * HL_BUF, HOROW = 132;
constexpr int HL_ST = 45056, HG_GRP_BYTES = 45056 + 12288;
static_assert(HL_O + 16 * HOROW * 4 <= HG_GRP_BYTES && 2 * HG_GRP_BYTES <= RING_BYTES, "hgrn LDS map");
typedef short bf16x8_t __attribute__((ext_vector_type(8)));
typedef __bf16 bf16n2_t __attribute__((ext_vector_type(2)));
__device__ __forceinline__ unsigned cvtpk(float lo, float hi) { const f32x2 v = {lo, hi}; return __builtin_bit_cast(unsigned, __builtin_convertvector(v, bf16n2_t)); }
__device__ __forceinline__ void unpack8(const v4u w, float (&o)[8]) { o[0] = bflo(w.x); o[1] = bfhi(w.x); o[2] = bflo(w.y); o[3] = bfhi(w.y); o[4] = bflo(w.z); o[5] = bfhi(w.z); o[6] = bflo(w.w); o[7] = bfhi(w.w); }
__device__ __forceinline__ void hgrn_item_geom(int sc, int b, int& row0, int& ntok) { if (sc == 32) { row0 = ML + b * CTXL; ntok = CTXL; } else { row0 = b * SEQ + sc * SCT; ntok = SCT; } }

template <bool OUT, int DIR>
__device__ __forceinline__ void hgrn_run(const Frame& F, const bf16* QF, const float* LBVl, unsigned char* ws, float* PD, float* OFW, bf16* MIX, const float* hgain, int bh, int sc, int nchunk) {
    constexpr int dir = DIR;
    const int grp = F.wave >> 2, w = F.wave & 3, tg = F.tid & 255, lane = F.lane, n = lane & 15, g = lane >> 4;
    LAS unsigned char* L = F.lds + grp * HG_GRP_BYTES;
    const int b = bh >> 3, h = bh & 7; int row0, ntok; hgrn_item_geom(sc, b, row0, ntok);
    const int bd = bh * 2 + dir;
    float* slot = hst_slot(ws, bd, sc);
    f32x4 acc[8][2];
#pragma unroll
    for (int kb = 0; kb < 8; ++kb)
#pragma unroll
        for (int vb = 0; vb < 2; ++vb) acc[kb][vb] = (OUT && sc < 32) ? *(const GAS f32x4*)(slot + ((kb * 8 + 2 * w + vb) * 64 + lane) * 4) : (f32x4){0.f, 0.f, 0.f, 0.f};
    const int k = tg & 127, hf = (F.wave & 3) >> 1;
    const float lbk = LBVl[dir * HW + h * HD + k];
    float hg0 = 0.f, hg1 = 0.f; if (OUT) { hg0 = hgain[2 * lane]; hg1 = hgain[2 * lane + 1]; }
    float Pk = 1.0f;
    static_assert(OUT, "the staging image is handed over by the two barriers of an output chunk");
    const int ts = tg >> 4, sg = tg & 15;
    LAS unsigned char* ST = L + HL_ST;
    v4u wq, wz, wv;
#define HG_LOADROWS(cc) do { const int tt_ = (cc) * HC + ts, tok_ = dir ? ntok - 1 - tt_ : tt_; const GAS v4u* pr_ = (const GAS v4u*)(QF + (size_t)(row0 + tok_) * INW + h * HD + 8 * sg); \
        wq = pr_[0]; wz = pr_[(HW * (1 + dir)) / 8]; wv = pr_[3 * HW / 8]; } while (0)
#define HG_STOREROWS() do { LAS v4u* st_ = (LAS v4u*)(ST + ts * 256 + sg * 16); st_[0] = wq; st_[256] = wz; st_[512] = wv; } while (0)
    HG_LOADROWS(0); HG_STOREROWS(); if (nchunk > 1) HG_LOADROWS(1);
    __syncthreads();
    for (int c = 0; c < nchunk; ++c) {
        LAS unsigned char* LB = L + (c & 1) * HL_BUF;
        f32x2 pf_o[4] = {{0.f, 0.f}, {0.f, 0.f}, {0.f, 0.f}, {0.f, 0.f}}; unsigned pf_g[4] = {0u, 0u, 0u, 0u};
        if (OUT && DIR) {
#pragma unroll
            for (int ii = 0; ii < 4; ++ii) { const int tt = c * HC + 4 * w + ii, tok = ntok - 1 - tt; const size_t row = (size_t)(row0 + tok);
                pf_g[ii] = *(const GAS unsigned*)(QF + row * INW + 4 * HW + h * HD + 2 * lane);
                pf_o[ii] = *(const GAS f32x2*)(OFW + row * HW + h * HD + 2 * lane); } }
        unsigned rz[8], rv[8], rq[8];
#pragma unroll
        for (int j = 0; j < 8; ++j) { const LAS unsigned short* sp = (const LAS unsigned short*)(ST + (8 * hf + j) * 256) + k; rq[j] = sp[0]; rz[j] = sp[2048]; rv[j] = sp[4096]; }
        {
            float f[8], qs[8];
#pragma unroll
            for (int j = 0; j < 8; ++j) { f[j] = lbk + (1.0f - lbk) * sigmoidf_(bflo((unsigned)rz[j])); if (OUT) qs[j] = bflo((unsigned)rq[j]);
 }
            float ksc[8], qsc[8];
            if (hf == 0) { float lo = 1.0f;
#pragma unroll
                for (int j = 7; j >= 0; --j) { ksc[j] = lo; qsc[j] = __builtin_amdgcn_rcpf(fmaxf(lo, 1e-30f)); lo *= f[j]; }
                const float upp = c ? ((const LAS float*)(L + ((c & 1) ^ 1) * HL_BUF + HL_UP))[k] : 1.0f;
                ((LAS float*)(LB + HL_P7))[k] = lo * upp; }
            else { float up = 1.0f;
#pragma unroll
                for (int j = 0; j < 8; ++j) { up *= f[j]; qsc[j] = up; ksc[j] = __builtin_amdgcn_rcpf(fmaxf(up, 1e-30f)); }
                ((LAS float*)(LB + HL_UP))[k] = up; }
#pragma unroll
            for (int j = 0; j < 8; ++j) ksc[j] *= 1.0f - f[j];
            v4u kt; kt.x = cvtpk(ksc[0], ksc[1]); kt.y = cvtpk(ksc[2], ksc[3]); kt.z = cvtpk(ksc[4], ksc[5]); kt.w = cvtpk(ksc[6], ksc[7]);
            *(LAS v4u*)(LB + HL_KT + k * 32 + hf * 16) = kt;
            *(LAS v4u*)(LB + HL_VT + k * 32 + hf * 16) = (v4u){(unsigned)rv[0] | ((unsigned)rv[1] << 16), (unsigned)rv[2] | ((unsigned)rv[3] << 16), (unsigned)rv[4] | ((unsigned)rv[5] << 16), (unsigned)rv[6] | ((unsigned)rv[7] << 16)};
            if (OUT) {
#pragma unroll
                for (int j = 0; j < 8; ++j) { const unsigned kw2 = (j >> 1) == 0 ? kt.x : (j >> 1) == 1 ? kt.y : (j >> 1) == 2 ? kt.z : kt.w;
                    ((LAS unsigned short*)(LB + HL_KH + (8 * hf + j) * HROW))[k] = (unsigned short)(kw2 >> (16 * (j & 1)));
                    ((LAS unsigned short*)(LB + HL_QH + (8 * hf + j) * HROW))[k] = (unsigned short)cvtpk(qs[j] * qsc[j], 0.0f); } }
        }
        __syncthreads();
        if (c + 1 < nchunk) { HG_STOREROWS(); if (c + 2 < nchunk) HG_LOADROWS(c + 2); }
        if (!OUT && tg < 128) Pk *= ((const LAS float*)(LB + HL_P7))[tg];
        {
            f32x4 pv[8]; v2u qa[4], qb[4];
#pragma unroll
            for (int kb = 0; kb < 8; ++kb) pv[kb] = *(const LAS f32x4*)(LB + HL_P7 + (16 * kb + 4 * g) * 4);
            if (OUT) {
#pragma unroll
                for (int st = 0; st < 4; ++st) { qa[st] = *(const LAS v2u*)(LB + HL_QH + n * HROW + (32 * st + 4 * g) * 2); qb[st] = *(const LAS v2u*)(LB + HL_QH + n * HROW + (32 * st + 16 + 4 * g) * 2); } }
            __builtin_amdgcn_sched_barrier(0);
#pragma unroll
            for (int kb = 0; kb < 8; ++kb) { acc[kb][0] *= pv[kb]; acc[kb][1] *= pv[kb]; }
            bf16x8_t ka[4], qb2[4]; v2u vt[2], kt[8];
            if (OUT) {
#pragma unroll
                for (int st = 0; st < 4; ++st) { ka[st] = *(const LAS bf16x8_t*)(LB + HL_KH + n * HROW + (32 * st + 8 * g) * 2); qb2[st] = *(const LAS bf16x8_t*)(LB + HL_QH + n * HROW + (32 * st + 8 * g) * 2); } }
#pragma unroll
            for (int vb = 0; vb < 2; ++vb) vt[vb] = *(const LAS v2u*)(LB + HL_VT + (32 * w + 16 * vb + n) * 32 + g * 8);
            __builtin_amdgcn_sched_barrier(0);
            f32x4 o[2] = {{0.f, 0.f, 0.f, 0.f}, {0.f, 0.f, 0.f, 0.f}}; v4u ap = {0u, 0u, 0u, 0u};
            if (OUT) {
#pragma unroll
                for (int st = 0; st < 4; ++st) {
                    const v4u aq = {qa[st].x, qa[st].y, qb[st].x, qb[st].y};
#pragma unroll
                    for (int vb = 0; vb < 2; ++vb) { v4u bs; bs.x = cvtpk(acc[2 * st][vb][0], acc[2 * st][vb][1]); bs.y = cvtpk(acc[2 * st][vb][2], acc[2 * st][vb][3]);
                        bs.z = cvtpk(acc[2 * st + 1][vb][0], acc[2 * st + 1][vb][1]); bs.w = cvtpk(acc[2 * st + 1][vb][2], acc[2 * st + 1][vb][3]);
                        o[vb] = __builtin_amdgcn_mfma_f32_16x16x32_bf16(__builtin_bit_cast(bf16x8_t, aq), __builtin_bit_cast(bf16x8_t, bs), o[vb], 0, 0, 0); } }
                __builtin_amdgcn_sched_barrier(0);
#pragma unroll
                for (int kb = 0; kb < 8; ++kb) kt[kb] = *(const LAS v2u*)(LB + HL_KT + (16 * kb + n) * 32 + g * 8);
                __builtin_amdgcn_sched_barrier(0);
                f32x4 at = {0.f, 0.f, 0.f, 0.f};
#pragma unroll
                for (int st = 0; st < 4; ++st) at = __builtin_amdgcn_mfma_f32_16x16x32_bf16(ka[st], qb2[st], at, 0, 0, 0);
#pragma unroll
                for (int r = 0; r < 4; ++r) at[r] = (4 * g + r <= n) ? at[r] : 0.0f;
                ap.x = cvtpk(at[0], at[1]); ap.y = cvtpk(at[2], at[3]);
            }
            v4u vf[2];
#pragma unroll
            for (int vb = 0; vb < 2; ++vb) vf[vb] = (v4u){vt[vb].x, vt[vb].y, 0u, 0u};
            if (OUT) {
#pragma unroll
                for (int vb = 0; vb < 2; ++vb) o[vb] = __builtin_amdgcn_mfma_f32_16x16x32_bf16(__builtin_bit_cast(bf16x8_t, ap), __builtin_bit_cast(bf16x8_t, vf[vb]), o[vb], 0, 0, 0); }
#pragma unroll
            for (int kb = 0; kb < 8; ++kb) { const v4u kf = {kt[kb].x, kt[kb].y, 0u, 0u};
#pragma unroll
                for (int vb = 0; vb < 2; ++vb) acc[kb][vb] = __builtin_amdgcn_mfma_f32_16x16x32_bf16(__builtin_bit_cast(bf16x8_t, kf), __builtin_bit_cast(bf16x8_t, vf[vb]), acc[kb][vb], 0, 0, 0); }
            if (OUT) {
#pragma unroll
                for (int vb = 0; vb < 2; ++vb)
#pragma unroll
                    for (int r = 0; r < 4; ++r) ((LAS float*)(L + HL_O))[(4 * g + r) * HOROW + 32 * w + 16 * vb + n] = o[vb][r]; }
        }
        if (OUT) {
            __syncthreads();
#pragma unroll
            for (int ii = 0; ii < 4; ++ii) { const int ti = 4 * w + ii, tt = c * HC + ti, tok = dir ? ntok - 1 - tt : tt; const size_t row = (size_t)(row0 + tok);
                const f32x2 ov = *(const LAS f32x2*)(L + HL_O + (ti * HOROW + 2 * lane) * 4); float o0 = ov.x, o1 = ov.y;
                if (dir == 0) *(GAS f32x2*)(OFW + row * HW + h * HD + 2 * lane) = ov;
                else { o0 += pf_o[ii].x; o1 += pf_o[ii].y;
                    const float rinv = rsqrtf(wave_sum(o0 * o0 + o1 * o1) * (1.0f / HD) + EPS);
                    const float g0 = bflo(pf_g[ii]), g1 = bfhi(pf_g[ii]);
                    *(GAS unsigned*)(MIX + row * D + h * HD + 2 * lane) = f2bf(o0 * rinv * hg0 * g0) | (f2bf(o1 * rinv * hg1 * g1) << 16); } }
        }
    }
    if (!OUT) {
        const LAS unsigned char* LBl = L + ((nchunk - 1) & 1) * HL_BUF;
#pragma unroll
        for (int kb = 0; kb < 8; ++kb) { const f32x4 u = *(const LAS f32x4*)(LBl + HL_UP + (16 * kb + 4 * g) * 4);
#pragma unroll
            for (int vb = 0; vb < 2; ++vb) { const f32x4 sv = acc[kb][vb] * u; const GAS f32x4* sp = (const GAS f32x4*)(slot + ((kb * 8 + 2 * w + vb) * 64 + lane) * 4);
                asm volatile("global_store_dwordx4 %0, %1, off sc1\n\ts_nop 1" :: "v"(sp), "v"(sv) : "memory"); } }
        if (tg < 128) PD[((size_t)bd * NSC + sc) * HD + tg] = Pk * ((const LAS float*)(LBl + HL_UP))[tg];
    }
}
constexpr int H2ROW = 272, H2_QH = 0, H2_KH = 32 * H2ROW, H2_PH = 4 * 32 * H2ROW - 2 * 1024 + 2 * 1024  , H2_O = 34816 + 2048, H2OROW = 132;
constexpr int H2_GRP_BYTES = 53760;
static_assert(H2_PH == 34816 && H2_O + 32 * H2OROW * 4 <= H2_GRP_BYTES && 2 * H2_GRP_BYTES <= RING_BYTES, "hgrn32 LDS map");
__device__ __forceinline__ int h2_kt(int b) { return b ? 0 : 17408; }
__device__ __forceinline__ int h2_vt(int b) { return b ? 8704 : 25600; }
template <bool OUT>
__device__ __forceinline__ void hgrn_run32(const Frame& F, const bf16* QF, const float* LBVl, unsigned char* ws, float* PD, float* OFW, bf16* MIX, const float* hgain, int bh, int sc, int dir, int nchunk) {
    const int grp = F.wave >> 2, w = F.wave & 3, tg = F.tid & 255, lane = F.lane, n = lane & 15, g = lane >> 4;
    LAS unsigned char* L = F.lds + grp * H2_GRP_BYTES;
    const int b = bh >> 3, h = bh & 7; int row0, ntok; hgrn_item_geom(sc, b, row0, ntok);
    const int bd = bh * 2 + dir;
    float* slot = hst_slot(ws, bd, sc);
    f32x4 acc[8][2];
#pragma unroll
    for (int kb = 0; kb < 8; ++kb)
#pragma unroll
        for (int vb = 0; vb < 2; ++vb) acc[kb][vb] = (OUT && sc < 32) ? *(const GAS f32x4*)(slot + ((kb * 8 + 2 * w + vb) * 64 + lane) * 4) : (f32x4){0.f, 0.f, 0.f, 0.f};
    if (OUT) VM_WAIT();
    const int k = tg & 127, hf = (F.wave & 3) >> 1;
    const float lbk = LBVl[dir * HW + h * HD + k];
    float hg0 = 0.f, hg1 = 0.f; if (OUT) { hg0 = hgain[lane]; hg1 = hgain[lane + 64]; }
    float Pk = 1.0f;
    unsigned short rz[16], rv[16], rq[16];
#pragma unroll
    for (int j = 0; j < 16; ++j) { const int tt = 16 * hf + j, tok = dir ? ntok - 1 - tt : tt; const bf16* pr = QF + (size_t)(row0 + tok) * INW + h * HD;
        rz[j] = pr[HW * (1 + dir) + k]; rv[j] = pr[3 * HW + k]; rq[j] = OUT ? pr[k] : (unsigned short)0; }
    for (int c = 0; c < nchunk; ++c) {
        const int pb_ = c & 1, ob = OUT ? 0 : pb_;
        LAS unsigned char* LKT = L + h2_kt(ob); LAS unsigned char* LVT = L + h2_vt(ob); LAS float* LPH = (LAS float*)(L + H2_PH + pb_ * 1024); LAS float* LUP = LPH + 128;
        {
            float f[16];
#pragma unroll
            for (int j = 0; j < 16; ++j) f[j] = lbk + (1.0f - lbk) * sigmoidf_(bflo((unsigned)rz[j]));
            float ksc[16], qsc[16];
            if (hf == 0) { float lo = 1.0f;
#pragma unroll
                for (int j = 15; j >= 0; --j) { ksc[j] = lo; if (OUT) qsc[j] = __builtin_amdgcn_rcpf(fmaxf(lo, 1e-30f)); lo *= f[j]; }
                const float upp = c ? ((const LAS float*)(L + H2_PH + (pb_ ^ 1) * 1024))[128 + k] : 1.0f;
                LPH[k] = lo * upp; }
            else { float up = 1.0f;
#pragma unroll
                for (int j = 0; j < 16; ++j) { up *= f[j]; if (OUT) qsc[j] = up; ksc[j] = __builtin_amdgcn_rcpf(fmaxf(up, 1e-30f)); }
                LUP[k] = up; }
#pragma unroll
            for (int j = 0; j < 16; ++j) ksc[j] *= 1.0f - f[j];
            unsigned kw[8], vw[8];
#pragma unroll
            for (int j = 0; j < 8; ++j) { kw[j] = cvtpk(ksc[2 * j], ksc[2 * j + 1]); vw[j] = (unsigned)rv[2 * j] | ((unsigned)rv[2 * j + 1] << 16); }
            *(LAS v4u*)(LKT + k * 64 + hf * 32) = (v4u){kw[0], kw[1], kw[2], kw[3]}; *(LAS v4u*)(LKT + k * 64 + hf * 32 + 16) = (v4u){kw[4], kw[5], kw[6], kw[7]};
            *(LAS v4u*)(LVT + k * 64 + hf * 32) = (v4u){vw[0], vw[1], vw[2], vw[3]}; *(LAS v4u*)(LVT + k * 64 + hf * 32 + 16) = (v4u){vw[4], vw[5], vw[6], vw[7]};
            if (OUT) {
#pragma unroll
                for (int j = 0; j < 16; ++j) { ((LAS unsigned short*)(L + H2_KH + (16 * hf + j) * H2ROW))[k] = (unsigned short)(kw[j >> 1] >> (16 * (j & 1)));
                    ((LAS unsigned short*)(L + H2_QH + (16 * hf + j) * H2ROW))[k] = (unsigned short)cvtpk(bflo((unsigned)rq[j]) * qsc[j], 0.0f); } }
        }
        if (c + 1 < nchunk) {
#pragma unroll
            for (int j = 0; j < 16; ++j) { const int tt = (c + 1) * 32 + 16 * hf + j, tok = dir ? ntok - 1 - tt : tt; const bf16* pr = QF + (size_t)(row0 + tok) * INW + h * HD;
                rz[j] = pr[HW * (1 + dir) + k]; rv[j] = pr[3 * HW + k]; if (OUT) rq[j] = pr[k]; } }
        float pf_o[8][2]; unsigned short pf_g[8][2];
        if (OUT) {
#pragma unroll
            for (int ii = 0; ii < 8; ++ii) { const int tt = c * 32 + 8 * w + ii, tok = dir ? ntok - 1 - tt : tt; const size_t row = (size_t)(row0 + tok);
                const bf16* gp = QF + row * INW + 4 * HW + h * HD; pf_g[ii][0] = gp[lane]; pf_g[ii][1] = gp[lane + 64];
                if (dir) { const float* op = OFW + row * HW + h * HD; pf_o[ii][0] = op[lane]; pf_o[ii][1] = op[lane + 64]; } else { pf_o[ii][0] = 0.f; pf_o[ii][1] = 0.f; } } }
        __syncthreads();
        if (!OUT && tg < 128) Pk *= LPH[tg];
        {
#pragma unroll
            for (int kb = 0; kb < 8; ++kb) { const f32x4 p = *(const LAS f32x4*)(LPH + 16 * kb + 4 * g); acc[kb][0] *= p; acc[kb][1] *= p; }
            f32x4 o[2][2] = {{{0.f, 0.f, 0.f, 0.f}, {0.f, 0.f, 0.f, 0.f}}, {{0.f, 0.f, 0.f, 0.f}, {0.f, 0.f, 0.f, 0.f}}};
            v4u ap[2] = {{0u, 0u, 0u, 0u}, {0u, 0u, 0u, 0u}};
            if (OUT) {
#pragma unroll
                for (int st = 0; st < 4; ++st) {
                    v4u bs[2];
#pragma unroll
                    for (int vb = 0; vb < 2; ++vb) { bs[vb].x = cvtpk(acc[2 * st][vb][0], acc[2 * st][vb][1]); bs[vb].y = cvtpk(acc[2 * st][vb][2], acc[2 * st][vb][3]);
                        bs[vb].z = cvtpk(acc[2 * st + 1][vb][0], acc[2 * st + 1][vb][1]); bs[vb].w = cvtpk(acc[2 * st + 1][vb][2], acc[2 * st + 1][vb][3]); }
#pragma unroll
                    for (int tb = 0; tb < 2; ++tb) { const LAS unsigned char* qp = L + H2_QH + (16 * tb + n) * H2ROW + (32 * st + 4 * g) * 2; const v2u qa = *(const LAS v2u*)qp, qb = *(const LAS v2u*)(qp + 32);
                        const v4u aq = {qa.x, qa.y, qb.x, qb.y};
#pragma unroll
                        for (int vb = 0; vb < 2; ++vb) o[tb][vb] = __builtin_amdgcn_mfma_f32_16x16x32_bf16(__builtin_bit_cast(bf16x8_t, aq), __builtin_bit_cast(bf16x8_t, bs[vb]), o[tb][vb], 0, 0, 0); } }
                f32x4 a00 = {0.f, 0.f, 0.f, 0.f}, a01 = a00, a11 = a00;
#pragma unroll
                for (int st = 0; st < 4; ++st) { const int ko = (32 * st + 8 * g) * 2;
                    const bf16x8_t k0 = *(const LAS bf16x8_t*)(L + H2_KH + n * H2ROW + ko), k1 = *(const LAS bf16x8_t*)(L + H2_KH + (16 + n) * H2ROW + ko);
                    const bf16x8_t q0 = *(const LAS bf16x8_t*)(L + H2_QH + n * H2ROW + ko), q1 = *(const LAS bf16x8_t*)(L + H2_QH + (16 + n) * H2ROW + ko);
                    a00 = __builtin_amdgcn_mfma_f32_16x16x32_bf16(k0, q0, a00, 0, 0, 0); a01 = __builtin_amdgcn_mfma_f32_16x16x32_bf16(k0, q1, a01, 0, 0, 0); a11 = __builtin_amdgcn_mfma_f32_16x16x32_bf16(k1, q1, a11, 0, 0, 0); }
#pragma unroll
                for (int r = 0; r < 4; ++r) { const bool keep = 4 * g + r <= n; a00[r] = keep ? a00[r] : 0.0f; a11[r] = keep ? a11[r] : 0.0f; }
                ap[0].x = cvtpk(a00[0], a00[1]); ap[0].y = cvtpk(a00[2], a00[3]);
                ap[1].x = cvtpk(a01[0], a01[1]); ap[1].y = cvtpk(a01[2], a01[3]); ap[1].z = cvtpk(a11[0], a11[1]); ap[1].w = cvtpk(a11[2], a11[3]);
            }
            v4u vf[2];
#pragma unroll
            for (int vb = 0; vb < 2; ++vb) { const LAS unsigned char* vp = LVT + (32 * w + 16 * vb + n) * 64 + g * 8; const v2u t0 = *(const LAS v2u*)vp, t1 = *(const LAS v2u*)(vp + 32); vf[vb] = (v4u){t0.x, t0.y, t1.x, t1.y}; }
            if (OUT) {
#pragma unroll
                for (int tb = 0; tb < 2; ++tb)
#pragma unroll
                    for (int vb = 0; vb < 2; ++vb) o[tb][vb] = __builtin_amdgcn_mfma_f32_16x16x32_bf16(__builtin_bit_cast(bf16x8_t, ap[tb]), __builtin_bit_cast(bf16x8_t, vf[vb]), o[tb][vb], 0, 0, 0); }
#pragma unroll
            for (int kb = 0; kb < 8; ++kb) { const LAS unsigned char* kp = LKT + (16 * kb + n) * 64 + g * 8; const v2u t0 = *(const LAS v2u*)kp, t1 = *(const LAS v2u*)(kp + 32); const v4u kf = {t0.x, t0.y, t1.x, t1.y};
#pragma unroll
                for (int vb = 0; vb < 2; ++vb) acc[kb][vb] = __builtin_amdgcn_mfma_f32_16x16x32_bf16(__builtin_bit_cast(bf16x8_t, kf), __builtin_bit_cast(bf16x8_t, vf[vb]), acc[kb][vb], 0, 0, 0); }
            if (OUT) {
#pragma unroll
                for (int tb = 0; tb < 2; ++tb)
#pragma unroll
                    for (int vb = 0; vb < 2; ++vb)
#pragma unroll
                        for (int r = 0; r < 4; ++r) ((LAS float*)(L + H2_O))[(16 * tb + 4 * g + r) * H2OROW + 32 * w + 16 * vb + n] = o[tb][vb][r]; }
        }
        if (OUT) {
            __syncthreads();
#pragma unroll
            for (int ii = 0; ii < 8; ++ii) { const int ti = 8 * w + ii, tt = c * 32 + ti, tok = dir ? ntok - 1 - tt : tt; const size_t row = (size_t)(row0 + tok);
                float o0 = ((const LAS float*)(L + H2_O))[ti * H2OROW + lane], o1 = ((const LAS float*)(L + H2_O))[ti * H2OROW + lane + 64];
                if (dir == 0) { float* op = OFW + row * HW + h * HD + lane; op[0] = o0; op[64] = o1; }
                else { o0 += pf_o[ii][0]; o1 += pf_o[ii][1];
                    const float rinv = rsqrtf(wave_sum(o0 * o0 + o1 * o1) * (1.0f / HD) + EPS);
                    const float g0 = bflo((unsigned)pf_g[ii][0]), g1 = bflo((unsigned)pf_g[ii][1]);
                    bf16* mp = MIX + row * D + h * HD + lane;
                    mp[0] = (bf16)f2bf(o0 * rinv * hg0 * g0); mp[64] = (bf16)f2bf(o1 * rinv * hg1 * g1); } }
        }
    }
    if (!OUT) {
        const LAS float* LUPl = (const LAS float*)(L + H2_PH + ((nchunk - 1) & 1) * 1024) + 128;
#pragma unroll
        for (int kb = 0; kb < 8; ++kb) { const f32x4 u = *(const LAS f32x4*)(LUPl + 16 * kb + 4 * g);
#pragma unroll
            for (int vb = 0; vb < 2; ++vb) { const f32x4 sv = acc[kb][vb] * u; const GAS f32x4* sp = (const GAS f32x4*)(slot + ((kb * 8 + 2 * w + vb) * 64 + lane) * 4);
                asm volatile("global_store_dwordx4 %0, %1, off sc1\n\ts_nop 1" :: "v"(sp), "v"(sv) : "memory"); } }
        if (tg < 128) PD[((size_t)bd * NSC + sc) * HD + tg] = Pk * LUPl[tg];
    }
}
__device__ __forceinline__ void hgrn_pass_b(const Frame& F, unsigned char* ws, const float* PD) {
    const int gtid = F.vcu * NTHR + F.tid, nthreads = F.G * NTHR;
    for (int idx = gtid; idx < 32 * HD * HD; idx += nthreads) {
        const int bd = idx >> 14, e = idx & 16383, k = hst_k_of(e), dir = bd & 1;
        float tmp[NSC], pv[NSC];
#pragma unroll
        for (int step = 0; step < NSC; ++step) { const int sc = step == 0 ? 32 : (dir == 0 ? step - 1 : 32 - step);
            tmp[step] = hst_slot(ws, bd, sc)[e]; pv[step] = PD[((size_t)bd * NSC + sc) * HD + k]; }
        float S = 0.f;
#pragma unroll
        for (int step = 0; step < NSC; ++step) { const int sc = step == 0 ? 32 : (dir == 0 ? step - 1 : 32 - step);
            hst_slot(ws, bd, sc)[e] = S; S = pv[step] * S + tmp[step]; }
    }
}

__device__ __forceinline__ void acc_bf8(float (&a)[8], const v4u w) { a[0] += bflo(w.x); a[1] += bfhi(w.x); a[2] += bflo(w.y); a[3] += bfhi(w.y); a[4] += bflo(w.z); a[5] += bfhi(w.z); a[6] += bflo(w.w); a[7] += bfhi(w.w); }
__device__ __forceinline__ void pool_v_chunk(const Frame& F, const bf16* QF, float* T, int chunk) {
    for (int u = 0; u < 16; ++u) { const int idx = (chunk * 16 + u) * NTHR + F.tid;
        const int m = idx >> 7, c8 = (idx & 127) * 8, hw = 1 << (c8 >> 8), b = m >> 14, r = (m >> 6) & 255, j = m & 63;
        const int lo = max(r - hw, 0), hi = min(r + hw, GRID_R);
        float a[8] = {0.f, 0.f, 0.f, 0.f, 0.f, 0.f, 0.f, 0.f};
        for (int rr = lo; rr < hi; ++rr) acc_bf8(a, *(const GAS v4u*)(QF + (size_t)(b * SEQ + rr * GRID_W + j) * INW + 5 * HW + c8));
        const float inv = 1.0f / (float)(hi - lo);
        *(GAS f32x4*)(T + (size_t)m * PW + c8) = (f32x4){a[0] * inv, a[1] * inv, a[2] * inv, a[3] * inv}; *(GAS f32x4*)(T + (size_t)m * PW + c8 + 4) = (f32x4){a[4] * inv, a[5] * inv, a[6] * inv, a[7] * inv}; }
}
__device__ __forceinline__ void pool_h_chunk(const Frame& F, const bf16* QF, const float* T, bf16* Dp, int chunk) {
    for (int u = 0; u < 16; ++u) { const int idx = (chunk * 16 + u) * NTHR + F.tid; if (idx >= M * 128) break;
        const int m = idx >> 7, c8 = (idx & 127) * 8, hw = 1 << (c8 >> 8);
        float a[8] = {0.f, 0.f, 0.f, 0.f, 0.f, 0.f, 0.f, 0.f}; float inv;
        if (m < ML) { const int j = m & 63, lo = max(j - hw, 0), hi = min(j + hw, GRID_W); const float* tp = T + (size_t)(m - j) * PW + c8;
            for (int jj = lo; jj < hi; ++jj) { const f32x4 t0 = *(const GAS f32x4*)(tp + (size_t)jj * PW), t1 = *(const GAS f32x4*)(tp + (size_t)jj * PW + 4);
                a[0] += t0.x; a[1] += t0.y; a[2] += t0.z; a[3] += t0.w; a[4] += t1.x; a[5] += t1.y; a[6] += t1.z; a[7] += t1.w; }
            inv = 1.0f / (float)(hi - lo); }
        else { const int t = (m - ML) & 255, lo = max(t - hw, 0), hi = min(t + hw, CTXL); const bf16* pp = QF + (size_t)(m - t) * INW + 5 * HW + c8;
            for (int tt = lo; tt < hi; ++tt) acc_bf8(a, *(const GAS v4u*)(pp + (size_t)tt * INW));
            inv = 1.0f / (float)(hi - lo); }
        const v4u pv = *(const GAS v4u*)(QF + (size_t)m * INW + 5 * HW + c8);
        v4u o; o.x = pk2(a[0] * inv - bflo(pv.x), a[1] * inv - bfhi(pv.x)); o.y = pk2(a[2] * inv - bflo(pv.y), a[3] * inv - bfhi(pv.y));
        o.z = pk2(a[4] * inv - bflo(pv.z), a[5] * inv - bfhi(pv.z)); o.w = pk2(a[6] * inv - bflo(pv.w), a[7] * inv - bfhi(pv.w));
        *(GAS v4u*)(Dp + (size_t)m * PW + c8) = o; }
}

__device__ __forceinline__ void pool_fused_item(const Frame& F, const bf16* QF, bf16* Dp, int item) {
    const int rs = item & 7, cb = (item >> 3) & 3, g = (item >> 5) & 3, b = item >> 7, hw = 1 << g, r0 = rs * 32;
    const int j = F.tid >> 3, oc = F.tid & 7, ch = g * 256 + cb * 64 + oc * 8;
    const bf16* base = QF + (size_t)(b * SEQ + j) * INW + 5 * HW + ch;
    bf16* dbase = Dp + (size_t)(b * SEQ + j) * PW + ch;
    LAS float* Tl = (LAS float*)F.lds;
    float S[8] = {0.f, 0.f, 0.f, 0.f, 0.f, 0.f, 0.f, 0.f};
    for (int rr = max(r0 - hw, 0); rr < min(r0 + hw, GRID_R); ++rr) acc_bf8(S, *(const GAS v4u*)(base + (size_t)rr * 64 * INW));
    v4u cen = *(const GAS v4u*)(base + (size_t)r0 * 64 * INW);
    const int jlo = max(j - hw, 0), jhi = min(j + hw, GRID_W); const float invj = 1.0f / (float)(jhi - jlo);
    __syncthreads();
    for (int r = r0; r < r0 + 32; ++r) {
        const bool he = r + hw < GRID_R, hl = r - hw >= 0, more = r + 1 < r0 + 32;
        v4u en = {0u, 0u, 0u, 0u}, lv = en, cn = en;
        if (more) { if (he) en = *(const GAS v4u*)(base + (size_t)(r + hw) * 64 * INW); if (hl) lv = *(const GAS v4u*)(base + (size_t)(r - hw) * 64 * INW); cn = *(const GAS v4u*)(base + (size_t)(r + 1) * 64 * INW); }
        const float invr = 1.0f / (float)(min(r + hw, GRID_R) - max(r - hw, 0));
        LAS float* Tb = Tl + ((r & 1) * 64 + j) * 64 + oc * 8;
        *(LAS f32x4*)Tb = (f32x4){S[0] * invr, S[1] * invr, S[2] * invr, S[3] * invr}; *(LAS f32x4*)(Tb + 4) = (f32x4){S[4] * invr, S[5] * invr, S[6] * invr, S[7] * invr};
        __syncthreads();
        f32x4 a0 = {0.f, 0.f, 0.f, 0.f}, a1 = a0;
        for (int jj = jlo; jj < jhi; ++jj) { const LAS float* tp = Tl + ((r & 1) * 64 + jj) * 64 + oc * 8; a0 += *(const LAS f32x4*)tp; a1 += *(const LAS f32x4*)(tp + 4); }
        float cv[8]; { cv[0] = bflo(cen.x); cv[1] = bfhi(cen.x); cv[2] = bflo(cen.y); cv[3] = bfhi(cen.y); cv[4] = bflo(cen.z); cv[5] = bfhi(cen.z); cv[6] = bflo(cen.w); cv[7] = bfhi(cen.w); }
        v4u o; o.x = pk2(a0[0] * invj - cv[0], a0[1] * invj - cv[1]); o.y = pk2(a0[2] * invj - cv[2], a0[3] * invj - cv[3]); o.z = pk2(a1[0] * invj - cv[4], a1[1] * invj - cv[5]); o.w = pk2(a1[2] * invj - cv[6], a1[3] * invj - cv[7]);
        *(GAS v4u*)(dbase + (size_t)r * 64 * PW) = o;
        if (more) { if (he) acc_bf8(S, en); if (hl) { float t[8] = {0.f, 0.f, 0.f, 0.f, 0.f, 0.f, 0.f, 0.f}; acc_bf8(t, lv);
#pragma unroll
                for (int e = 0; e < 8; ++e) S[e] -= t[e]; } cen = cn; }
    }
    __syncthreads();
}

#ifndef MK_XS16
#define MK_XS16 1
#endif
constexpr bool XS16 = MK_XS16;
#ifndef MK_ONE_LAUNCH
#define MK_ONE_LAUNCH 1
#endif
constexpr int PH_PER_LAYER = 12, N_PHASES = 2 + DEPTH * PH_PER_LAYER;
struct Args { const float* in[16]; float* out; unsigned char* ws; int ph_lo, ph_hi; };
static_assert(sizeof(Args) == 18 * 8 + 8, "Args has no padding");

__global__ void __launch_bounds__(NTHR, 2) fwd(Args args) {
    extern __shared__ __attribute__((aligned(16))) unsigned char lds_raw[];
    Frame F;
    F.lds = (LAS unsigned char*)lds_raw;
    F.tid = threadIdx.x; F.lane = F.tid & 63; F.wave = __builtin_amdgcn_readfirstlane(F.tid >> 6);
    F.G = gridDim.x; { const int bx = blockIdx.x; F.vcu = (F.G % 8 == 0) ? (bx % 8) * (F.G / 8) + bx / 8 : bx; }
    unsigned char* ws = args.ws;
    gu32* ctl = (gu32*)(ws + WS_CTL);
    for (int u = F.tid; u < (LDS_BYTES - LDSCTL_OFF) / 4; u += NTHR) ((LAS unsigned*)(F.lds + LDSCTL_OFF))[u] = 0u;
    __syncthreads();
    const int lo = args.ph_lo, hi = args.ph_hi;
    const bool multi = (hi - lo) > 1;
    XcdBarrier bar; bar.bar = (unsigned*)(ctl + CW_BAR); bar.x = 0; bar.st = nullptr;
    if (multi) bar = xcd_barrier_post((unsigned*)(ctl + CW_BAR), (volatile LAS unsigned*)(F.lds + MISC_OFF) + 8);
#define IN(k) (lo <= (k) && (k) < hi)
static_assert(WC_IL == 42112 && DEPTH == 2, "the WC_SLOT item ranges below split the second layer's 42112 copy items");
#define WC_SLOT(a, b, ntail) do { if (F.G == 256 && l == 0 && (int)blockIdx.x >= (ntail)) { __syncthreads(); REFRESH(); weight_copy(F, args.in, ws, WC_IL + (a), WC_IL + (b), ((int)blockIdx.x - (ntail)) * NWAVES + F.wave, (256 - (ntail)) * NWAVES); } } while (0)
#define DIR_SEAM() do { VM_WAIT(); __syncthreads(); if (F.wave == 0) { __builtin_amdgcn_fence(__ATOMIC_ACQUIRE, "agent"); VM_WAIT(); } __syncthreads(); } while (0)
#define REFRESH() do { int t_ = threadIdx.x; asm volatile("" : "+v"(t_)); F.tid = t_; F.lane = t_ & 63; F.wave = __builtin_amdgcn_readfirstlane(t_ >> 6); } while (0)
#define SEAM(k) do { if (IN(k) && IN((k) + 1)) xcd_barrier(bar); } while (0)

    const float* x_in = args.in[0]; const float* ctx_in = args.in[2];
    void* xs = (void*)(ws + WS_XS); void* cs = (void*)(ws + WS_CTXS);
    const float* MOD = (const float*)(ws + WS_MOD); const float* LBV = (const float*)(ws + WS_LBV);
    bf16* ABUF = (bf16*)(ws + WS_ABUF); bf16* MIX = (bf16*)(ws + WS_MIX); bf16* HBUF = (bf16*)(ws + WS_HBUF); bf16* YBUF = (bf16*)(ws + WS_YBUF);
    float* TBUF = (float*)(ws + WS_ABUF); float* OFW = args.out; bf16* DBUF = (bf16*)(ws + WS_YBUF);
    float* PD = (float*)(ws + WS_PD); float* YP = (float*)(ws + WS_YP);

    if (IN(0)) { REFRESH(); p0_prologue(F, args.in, ws); }
    SEAM(0);
    if (IN(1)) { REFRESH(); NormP P{x_in, ctx_in, nullptr, nullptr, nullptr, ABUF, nullptr, nullptr, MOD, args.in[6], YP, 0, 0, 0, 0, 1, 0};
        norm_phase<false, true, false, XS16>(F, P, true); }
    SEAM(1);

    for (int l = 0; l < DEPTH; ++l) {
        const int pb = 2 + l * PH_PER_LAYER; const bool last = (l == DEPTH - 1);
        const float* modl = MOD + (size_t)l * 3 * NMOD * D; const float* gl = args.in[6] + (size_t)l * 6 * D;
        if (IN(pb + 0)) { REFRESH(); pg8::Gemm g{ABUF, (const bf16*)(ws + WS_W1T + (size_t)(l * 2 + 0) * W1T_SZ), D, D, D, 0}; pg8::StaticOrder S; S.init(ML, 2 * DFF, F.G, (int)blockIdx.x, D / 64, 2, 1);
            pg8::EpiSwiglu E{HBUF, DFF}; pg8::gemm_phase<pg8::EpiSwiglu, pg8::StaticOrder, true, true>(F.lds, g, S, E); WC_SLOT(0, 8843, 88); }
        SEAM(pb + 0);
        if (IN(pb + 1)) { REFRESH(); pg8::Gemm g{HBUF, (const bf16*)(ws + WS_W2T + (size_t)(l * 2 + 0) * W2T_SZ), DFF, DFF, DFF, 0}; pg8::StaticOrder S; S.init(ML, D, F.G, (int)blockIdx.x, DFF / 64, 2, 4);
            pg8::EpiBf16 E{YBUF, D, 0, nullptr, nullptr, YP, ML, (size_t)MC * D, 0u}; pg8::gemm_phase<pg8::EpiBf16, pg8::StaticOrder, true, true>(F.lds, g, S, E); WC_SLOT(8843, 15581, 64); }
        SEAM(pb + 1);
        if (IN(pb + 2)) { REFRESH();
            if (l == 0) { NormP P{x_in, ctx_in, xs, cs, YBUF, ABUF, modl, gl, modl, gl, YP, 2, 1, 2, 3, 4, 1}; norm_phase<true, true, false, XS16>(F, P, true); }
            else { NormP P{xs, cs, xs, cs, YBUF, ABUF, modl, gl, modl, gl, YP, 2, 1, 2, 3, 4, 1}; norm_phase<true, true, XS16, XS16>(F, P, true); } }
        SEAM(pb + 2);
        if (IN(pb + 3)) { REFRESH(); pg8::Gemm g{ABUF, (const bf16*)(ws + WS_WINT + (size_t)l * WINT_SZ), D, D, D, 0}; pg8::StaticOrder S; S.init(ML, INW, F.G, (int)blockIdx.x, D / 64, 2, 1);
            pg8::EpiBf16 E{HBUF, INW, 0, nullptr, nullptr, nullptr, 0, 0, 0x000F000Fu}; pg8::gemm_phase<pg8::EpiBf16, pg8::StaticOrder, true, true>(F.lds, g, S, E); WC_SLOT(15581, 26530, 48); }
        SEAM(pb + 3);
        if (IN(pb + 4)) { REFRESH();
            const int nj = (last || F.G != 256) ? (536 + F.G - 1) / F.G : 3;
            for (int j = 0; j < nj; ++j) {
                int kind = -1, idx = 0;
                const int v = F.vcu;
                if (last || F.G != 256) { const int it = v + j * F.G; if (it < 512) { kind = 0; idx = it; } else if (it < 528) { kind = 1; idx = it - 512; } else if (!last && it < 536) { kind = 2; idx = it - 528; } }
                else if (v < 8) { if (j == 0) { kind = 2; idx = v; } }
                else if (j == 0) { kind = 0; idx = v - 8; }
                else if (j == 1) { kind = 0; idx = 248 + v - 8; }
                else if (v < 24) { kind = 0; idx = 496 + v - 8; }
                else if (v < 40) { kind = 1; idx = v - 24; }
                if (kind < 0) continue;
                const int grp = F.wave >> 2;
                if (kind == 2) { const int bh = 2 * idx + grp;
                    hgrn_run<true, 0>(F, HBUF, LBV + (size_t)l * 2 * HW, ws, PD, OFW, MIX, args.in[11] + (size_t)l * HD, bh, 32, 16); DIR_SEAM();
                    hgrn_run<true, 1>(F, HBUF, LBV + (size_t)l * 2 * HW, ws, PD, OFW, MIX, args.in[11] + (size_t)l * HD, bh, 32, 16); DIR_SEAM(); }
                else { int bh, dir, sc; if (kind == 0) { sc = idx & 31; dir = (idx >> 5) & 1; bh = 2 * (idx >> 6) + grp; } else { const int r = 2 * idx + grp; sc = 32; dir = r & 1; bh = r >> 1; }
                    hgrn_run32<false>(F, HBUF, LBV + (size_t)l * 2 * HW, ws, PD, nullptr, nullptr, nullptr, bh, sc, dir, kind == 0 ? 16 : 8); __syncthreads(); }
            }
            if (F.G == 256) { const int v0 = last ? 16 : 40;
                if (F.vcu >= v0) for (int it = F.vcu - v0; it < 256; it += 256 - v0) pool_fused_item(F, HBUF, DBUF, it); } }
        SEAM(pb + 4);
        if (IN(pb + 5)) { REFRESH(); hgrn_pass_b(F, ws, PD);
            if (F.G != 256) for (int it = F.vcu; it < 256; it += F.G) pool_fused_item(F, HBUF, DBUF, it);
            for (int it = ML * 128 / (16 * NTHR) + F.vcu; it < M * 128 / (16 * NTHR); it += F.G) pool_h_chunk(F, HBUF, TBUF, DBUF, it); }
        SEAM(pb + 5);
        if (IN(pb + 6)) { REFRESH();
            for (int it = F.vcu; it < 256; it += F.G) { const int sc = it & 31, bh = 2 * (it >> 5) + (F.wave >> 2);

                hgrn_run<true, 0>(F, HBUF, LBV + (size_t)l * 2 * HW, ws, PD, OFW, MIX, args.in[11] + (size_t)l * HD, bh, sc, 32); DIR_SEAM();
                hgrn_run<true, 1>(F, HBUF, LBV + (size_t)l * 2 * HW, ws, PD, OFW, MIX, args.in[11] + (size_t)l * HD, bh, sc, 32); DIR_SEAM(); }
            __syncthreads();
            pg8::Gemm g{DBUF, (const bf16*)(ws + WS_WPT + (size_t)l * WPT_SZ), PW, 256, 256, 256}; pg8::StaticOrder S; S.init(ML, PW, F.G, (int)blockIdx.x, 256 / 64, last ? 0 : 2, 1);
            pg8::EpiBf16 E{MIX, D, HW, args.in[13] + (size_t)l * PW, args.in[14] + (size_t)l * PW, nullptr, 0, 0, 0u}; pg8::gemm_phase<pg8::EpiBf16, pg8::StaticOrder, true, true>(F.lds, g, S, E); }
        SEAM(pb + 6);
        if (IN(pb + 7)) { REFRESH(); pg8::Gemm g{MIX, (const bf16*)(ws + WS_WOT + (size_t)l * WOT_SZ), D, D, D, 0}; pg8::StaticOrder S; S.init(ML, D, F.G, (int)blockIdx.x, D / 64, last ? 0 : 2, 4);
            pg8::EpiBf16 E{YBUF, D, 0, nullptr, nullptr, YP, ML, (size_t)MC * D, 0u}; pg8::gemm_phase<pg8::EpiBf16, pg8::StaticOrder, true, true>(F.lds, g, S, E); }
        SEAM(pb + 7);
        if (IN(pb + 8)) { REFRESH(); NormP P{xs, cs, xs, cs, YBUF, ABUF, modl, gl, modl, gl, YP, 5, 3, 4, 6, 7, 0};
            norm_phase<true, true, XS16, XS16>(F, P, !last); }
        SEAM(pb + 8);
        if (IN(pb + 9)) { REFRESH(); pg8::Gemm g{ABUF, (const bf16*)(ws + WS_W1T + (size_t)(l * 2 + 1) * W1T_SZ), D, D, D, 0}; pg8::StaticOrder S; S.init(ML, 2 * DFF, F.G, (int)blockIdx.x, D / 64, last ? 0 : 2, 1);
            pg8::EpiSwiglu E{HBUF, DFF}; pg8::gemm_phase<pg8::EpiSwiglu, pg8::StaticOrder, true, true>(F.lds, g, S, E); WC_SLOT(26530, 35373, 88); }
        SEAM(pb + 9);
        if (IN(pb + 10)) { REFRESH(); pg8::Gemm g{HBUF, (const bf16*)(ws + WS_W2T + (size_t)(l * 2 + 1) * W2T_SZ), DFF, DFF, DFF, 0}; pg8::StaticOrder S; S.init(ML, D, F.G, (int)blockIdx.x, DFF / 64, last ? 0 : 2, 4);
            pg8::EpiBf16 E{YBUF, D, 0, nullptr, nullptr, YP, ML, (size_t)MC * D, 0u}; pg8::gemm_phase<pg8::EpiBf16, pg8::StaticOrder, true, true>(F.lds, g, S, E); WC_SLOT(35373, 42112, 64); }
        SEAM(pb + 10);
        if (IN(pb + 11)) { REFRESH();
            if (!last) { NormP P{xs, cs, xs, cs, YBUF, ABUF, modl, gl, modl + 3 * NMOD * D, gl + 6 * D, YP, 8, 5, 0, 0, 1, 1}; norm_phase<true, true, XS16, XS16>(F, P, true); }
            else { NormP P{xs, cs, args.out, cs, YBUF, nullptr, modl, gl, nullptr, nullptr, YP, 8, 5, 0, 0, 0, 1}; norm_phase<true, false, XS16, false>(F, P, false); } }
        SEAM(pb + 11);
    }
#if defined(STOP_PH)
#ifndef DUMP_F32
#define DUMP_F32 0
#endif
    if (lo == 1000) {
        const bf16* B = (const bf16*)(ws + (size_t)DUMP_WS);
        for (size_t i = (size_t)blockIdx.x * NTHR + threadIdx.x; i < (size_t)ML * D; i += (size_t)gridDim.x * NTHR) args.out[i] = DUMP_F32 ? ((const float*)B)[i] : bflo((unsigned)B[i]);
    }
#endif
#undef IN
#undef SEAM
}

extern "C" void kernel_launch(void* const* d_in, const int* in_sizes, int n_in, void* d_out, int out_size, void* d_ws, size_t ws_size, hipStream_t stream) {
    static int grid = 0;
    if (grid == 0) {
        if (n_in != 16 || in_sizes[0] != ML * D || out_size != ML * D || ws_size < WS_END) { fprintf(stderr, "kernel_launch: unexpected shapes: n_in %d in0 %d out %d ws %zu (need %zu); nothing launched\n", n_in, n_in > 0 ? in_sizes[0] : -1, out_size, ws_size, (size_t)WS_END); grid = -1; return; }
        int dev = 0, cus = 0, per_cu = 0;
        if (hipGetDevice(&dev) != hipSuccess || hipDeviceGetAttribute(&cus, hipDeviceAttributeMultiprocessorCount, dev) != hipSuccess) { grid = -1; return; }
        if (hipFuncSetAttribute((const void*)fwd, hipFuncAttributeMaxDynamicSharedMemorySize, LDS_BYTES) != hipSuccess) { fprintf(stderr, "kernel_launch: hipFuncSetAttribute failed\n"); grid = -1; return; }
        if (hipOccupancyMaxActiveBlocksPerMultiprocessor(&per_cu, (const void*)fwd, NTHR, LDS_BYTES) != hipSuccess || per_cu < 1) fprintf(stderr, "kernel_launch: occupancy query reports %d\n", per_cu);
        (void)hipGetLastError();
        grid = cus;
    }
    if (grid < 0) return;
    if (hipMemsetAsync((char*)d_ws, 0, ZERO_BYTES, stream) != hipSuccess) { fprintf(stderr, "kernel_launch: memset failed\n"); return; }
    Args a{};
    for (int i = 0; i < 16; ++i) a.in[i] = (const float*)d_in[i];
    a.out = (float*)d_out; a.ws = (unsigned char*)d_ws;
#if MK_ONE_LAUNCH
    a.ph_lo = 0; a.ph_hi = N_PHASES;
    hipLaunchKernelGGL(fwd, dim3(grid), dim3(NTHR), LDS_BYTES, stream, a);
#else
#if defined(STOP_PH)
    for (int p = 0; p < STOP_PH; ++p) { a.ph_lo = p; a.ph_hi = p + 1; hipLaunchKernelGGL(fwd, dim3(grid), dim3(NTHR), LDS_BYTES, stream, a); }
    a.ph_lo = 1000; a.ph_hi = 1001; hipLaunchKernelGGL(fwd, dim3(grid), dim3(NTHR), LDS_BYTES, stream, a);
#else
    for (int p = 0; p < N_PHASES; ++p) { a.ph_lo = p; a.ph_hi = p + 1; hipLaunchKernelGGL(fwd, dim3(grid), dim3(NTHR), LDS_BYTES, stream, a); }
#endif
#endif
    const hipError_t le = hipPeekAtLastError();
    if (le != hipSuccess) fprintf(stderr, "kernel_launch: launch failed: %s\n", hipGetErrorName(le));
}
```

```cpp
#include <hip/hip_runtime.h>
#include <cstdio>
#include <cstdint>
namespace pg8 {
#define PG8_LAS __attribute__((address_space(3)))
typedef unsigned short bf16_t;
typedef short bf16x8 __attribute__((ext_vector_type(8)));
typedef float f32x4 __attribute__((ext_vector_type(4)));
typedef unsigned u32x4 __attribute__((ext_vector_type(4)));
constexpr int BM = 256, BK = 64, HALF = 128, HTB = HALF * BK * 2  , STAGE_BYTES = 8 * HTB, NXCD = 8, WGM = 4;

__host__ __device__ __forceinline__ int lds_byte(int r, int c) { const int st = (r >> 4) * 2 + (c >> 5), rr = r & 15, cc = c & 31, ob = rr * 64 + cc * 2; return st * 1024 + (ob ^ (((ob >> 9) & 1) << 5)); }
__host__ __device__ __forceinline__ void stage_rc(int b, int& R, int& C) { const int st = b / 1024, sb = b % 1024, swz = sb ^ (((sb >> 9) & 1) << 5); R = (st >> 1) * 16 + swz / 64; C = (st & 1) * 32 + (swz % 64) / 2; }
__host__ __device__ __forceinline__ int perm32(int rho) { const int n = rho >> 4, i = rho & 15; return 8 * (i >> 2) + 4 * n + (i & 3); }

struct Unit { int pm, pn, kt0, nkt; };
struct Gemm { const bf16_t* A; const bf16_t* Bt; int lda, ldb, K, a_pn_off; };

struct StaticOrder {
    int nM, nN, nwg, G, c, nkt, tail_pm0, tail_npm, nsplit;
    __host__ __device__ void init(int M, int N, int G_, int c_, int nkt_, int tail_npm_ = 0, int nsplit_ = 1) { nM = M / BM; nN = N / BM; nwg = nM * nN; G = G_; c = c_; nkt = nkt_; tail_pm0 = nM; tail_npm = tail_npm_; nsplit = nsplit_; }
    __host__ __device__ bool next(int i, Unit& u) const {
        const long L = (long)i * G + c; int pm, pn, kt0 = 0, nk = nkt;
        if (L >= nwg) { int t = (int)(L - nwg); if (t >= tail_npm * nN * nsplit) return false; pn = t % nN; t /= nN; pm = tail_pm0 + t % tail_npm; nk = nkt / nsplit; kt0 = (t / tail_npm) * nk; }
        else {
            int wgid = (int)L; { const int q = nwg / NXCD, r = nwg % NXCD, xcd = wgid % NXCD, off = wgid / NXCD; wgid = (xcd < r ? xcd * (q + 1) : r * (q + 1) + (xcd - r) * q) + off; }
            const int nig = WGM * nN, gid = wgid / nig, fm = gid * WGM, gsz = (nM - fm) < WGM ? (nM - fm) : WGM;
            pm = fm + ((wgid % nig) % gsz); pn = (wgid % nig) / gsz; }
        u.pm = pm; u.pn = pn; u.kt0 = kt0; u.nkt = nk; return true;
    }
    __device__ __forceinline__ void a_ready(const Unit&) const {}
    __device__ __forceinline__ void done(const Unit&) const {}
};


typedef float f32x2 __attribute__((ext_vector_type(2)));
typedef __bf16 bf16n2e_t __attribute__((ext_vector_type(2)));
__device__ __forceinline__ unsigned cvt_pk_bf16(float lo, float hi) { const f32x2 v = {lo, hi}; return __builtin_bit_cast(unsigned, __builtin_convertvector(v, bf16n2e_t)); }

struct EpiBf16 {
    static constexpr bool PERM = true, AFTER_DRAIN = false;
    bf16_t* O; int ldc; int col_off; const float* bias; const float* scale; float* part; int part_row0; size_t part_stride; unsigned silu_tiles;
    __device__ __forceinline__ void operator()(const f32x4 (&acc)[2][2][4][2], const Unit& u, int wr, int wc, int fr, int fq) const {
        const int row0 = u.pm * BM + wr * 64 + fr; const int bcol0 = u.pn * BM + wc * 32 + 8 * fq, col0 = col_off + bcol0;
        if (part != nullptr && row0 >= part_row0) {
            float* pb = part + (size_t)(u.kt0 / u.nkt) * part_stride + (size_t)(row0 - part_row0) * ldc + bcol0;
#pragma unroll
            for (int bj = 0; bj < 2; ++bj)
#pragma unroll
                for (int ai = 0; ai < 2; ++ai)
#pragma unroll
                    for (int m = 0; m < 4; ++m) { float* rp = pb + (size_t)(ai * HALF + m * 16) * ldc + bj * HALF; *(f32x4*)rp = acc[ai][bj][m][0]; *(f32x4*)(rp + 4) = acc[ai][bj][m][1]; }
            return;
        }
#pragma unroll
        for (int bj = 0; bj < 2; ++bj) {
            f32x4 b0 = {0.f, 0.f, 0.f, 0.f}, b1 = b0, s0 = {1.f, 1.f, 1.f, 1.f}, s1 = s0;
            if (bias) { b0 = *(const f32x4*)(bias + bcol0 + bj * HALF); b1 = *(const f32x4*)(bias + bcol0 + bj * HALF + 4); }
            if (scale) { s0 = *(const f32x4*)(scale + bcol0 + bj * HALF); s1 = *(const f32x4*)(scale + bcol0 + bj * HALF + 4); }
#pragma unroll
            for (int ai = 0; ai < 2; ++ai)
#pragma unroll
                for (int m = 0; m < 4; ++m) { bf16_t* rowp = O + (size_t)(row0 + ai * HALF + m * 16) * ldc + col0 + bj * HALF;
                    f32x4 v0 = (acc[ai][bj][m][0] + b0) * s0, v1 = (acc[ai][bj][m][1] + b1) * s1;
                    if ((silu_tiles >> u.pn) & 1u) {
#pragma unroll
                        for (int j = 0; j < 4; ++j) { v0[j] *= __builtin_amdgcn_rcpf(1.0f + __builtin_amdgcn_exp2f(v0[j] * -1.44269504089f)); v1[j] *= __builtin_amdgcn_rcpf(1.0f + __builtin_amdgcn_exp2f(v1[j] * -1.44269504089f)); } }
                    u32x4 w; w.x = cvt_pk_bf16(v0[0], v0[1]); w.y = cvt_pk_bf16(v0[2], v0[3]); w.z = cvt_pk_bf16(v1[0], v1[1]); w.w = cvt_pk_bf16(v1[2], v1[3]);
                    *(u32x4*)rowp = w; }
        }
    }
};
struct EpiSwiglu {
    static constexpr bool PERM = true, AFTER_DRAIN = false;
    bf16_t* H; int ldc;
    __device__ __forceinline__ void operator()(const f32x4 (&acc)[2][2][4][2], const Unit& u, int wr, int wc, int fr, int fq) const {
        const int row0 = u.pm * BM + wr * 64 + fr, col0 = u.pn * HALF + wc * 32 + 8 * fq;
#pragma unroll
        for (int ai = 0; ai < 2; ++ai)
#pragma unroll
            for (int m = 0; m < 4; ++m) { bf16_t* rowp = H + (size_t)(row0 + ai * HALF + m * 16) * ldc + col0;
                f32x4 o[2];
#pragma unroll
                for (int n = 0; n < 2; ++n) { const f32x4 gt = acc[ai][0][m][n], up = acc[ai][1][m][n];
#pragma unroll
                    for (int j = 0; j < 4; ++j) { const float e = __builtin_amdgcn_exp2f(gt[j] * -1.44269504089f); o[n][j] = gt[j] * __builtin_amdgcn_rcpf(1.0f + e) * up[j]; } }
                u32x4 w; w.x = cvt_pk_bf16(o[0][0], o[0][1]); w.y = cvt_pk_bf16(o[0][2], o[0][3]); w.z = cvt_pk_bf16(o[1][0], o[1][1]); w.w = cvt_pk_bf16(o[1][2], o[1][3]);
                __builtin_nontemporal_store(w, (u32x4*)rowp); }
    }
};

template <class Epi, class Sched, bool ALIGN_EPI = false, bool SP2 = false>
__device__ __forceinline__ void gemm_phase(PG8_LAS unsigned char* lds, const Gemm g, const Sched& S, const Epi& E) {
    int tid_ = threadIdx.x; asm volatile("" : "+v"(tid_));
    const int tid = tid_, wid = __builtin_amdgcn_readfirstlane(tid >> 6), lane = tid & 63, wr = wid >> 2, wc = wid & 3, fr = lane & 15, fq = lane >> 4;
    const int lda = g.lda, ldb = g.ldb;
    unsigned voffA[2], voffB[2];
#pragma unroll
    for (int i = 0; i < 2; ++i) { int R, C; stage_rc(tid * 16 + i * 8192, R, C); const int Rb = Epi::PERM ? ((R & ~31) + perm32(R & 31)) : R;
        voffA[i] = (unsigned)(R * lda + C) * 2u; voffB[i] = (unsigned)(Rb * ldb + C) * 2u; }
    const size_t kstep = (size_t)(BK * 2);
    const size_t hstepA = (size_t)HALF * lda * 2, hstepB = (size_t)HALF * ldb * 2;
    const size_t tstepA = 2 * hstepA, tstepB = 2 * hstepB; const size_t pnoffA = (size_t)g.a_pn_off * 2;
    const unsigned ldsw = (unsigned)wid * 1024u;
    const int aoff = lds_byte(wr * 64 + fr, fq * 8), boff = lds_byte(wc * 32 + fr, fq * 8);
#define PG8_SA(b, h) (((b) * 2 + (h)) * HTB)
#define PG8_SB(b, h) ((4 + (b) * 2 + (h)) * HTB)
#define PG8_STAGE(bufoff, gbase, voff) do { _Pragma("unroll") for (int _i = 0; _i < 2; ++_i) \
        __builtin_amdgcn_global_load_lds((const unsigned*)((const char*)(gbase) + (voff)[_i]), (PG8_LAS unsigned*)(lds + (bufoff) + ldsw + _i * 8192), 16, 0, 0); } while (0)
#define PG8_LDA(dst, b, h) do { _Pragma("unroll") for (int m = 0; m < 4; ++m) _Pragma("unroll") for (int k = 0; k < 2; ++k) dst[m][k] = *(const PG8_LAS bf16x8*)(lds + PG8_SA(b, h) + aoff + m * 2048 + k * 1024); } while (0)
#define PG8_LDB(dst, b, h) do { _Pragma("unroll") for (int n = 0; n < 2; ++n) _Pragma("unroll") for (int k = 0; k < 2; ++k) dst[n][k] = *(const PG8_LAS bf16x8*)(lds + PG8_SB(b, h) + boff + n * 2048 + k * 1024); } while (0)
#define PG8_MMA(ai, bj, At, Bt) do { __builtin_amdgcn_s_setprio(1); _Pragma("unroll") for (int m = 0; m < 4; ++m) _Pragma("unroll") for (int n = 0; n < 2; ++n) _Pragma("unroll") for (int k = 0; k < 2; ++k) \
        acc[ai][bj][m][n] = __builtin_amdgcn_mfma_f32_16x16x32_bf16(Bt[n][k], At[m][k], acc[ai][bj][m][n], 0, 0, 0); __builtin_amdgcn_s_setprio(0); } while (0)
#define PG8_WAIT_V(n) asm volatile("s_waitcnt vmcnt(" #n ")" ::: "memory")
#define PG8_WAIT_L(n) asm volatile("s_waitcnt lgkmcnt(" #n ")" ::: "memory")
#define PG8_BAR __builtin_amdgcn_s_barrier()
#define PG8_SCHED __builtin_amdgcn_sched_barrier(0)
    Unit cur, nxt; int ui = 0;
    if (!S.next(0, cur)) return;
    f32x4 acc[2][2][4][2];
#pragma unroll
    for (int a = 0; a < 2; ++a)
#pragma unroll
        for (int b = 0; b < 2; ++b)
#pragma unroll
            for (int m = 0; m < 4; ++m)
#pragma unroll
                for (int n = 0; n < 2; ++n) acc[a][b][m][n] = (f32x4){0.f, 0.f, 0.f, 0.f};
    bf16x8 At[4][2], B0[2][2], B1[2][2];
    const char* cA = (const char*)g.A + (size_t)cur.pm * tstepA + (size_t)cur.pn * pnoffA + (size_t)cur.kt0 * kstep; const char* cB = (const char*)g.Bt + (size_t)cur.pn * tstepB + (size_t)cur.kt0 * kstep;
    S.a_ready(cur);
    if constexpr (SP2) {
        PG8_STAGE(PG8_SB(0, 0), cB, voffB); PG8_STAGE(PG8_SB(0, 1), cB + hstepB, voffB); PG8_STAGE(PG8_SA(0, 0), cA, voffA); PG8_STAGE(PG8_SA(0, 1), cA + hstepA, voffA);
        if (wr == 1) PG8_BAR;
        PG8_WAIT_V(2); PG8_BAR;
        PG8_STAGE(PG8_SB(1, 0), cB + kstep, voffB); PG8_STAGE(PG8_SA(1, 0), cA + kstep, voffA); PG8_STAGE(PG8_SB(1, 1), cB + hstepB + kstep, voffB);
        PG8_WAIT_V(6); PG8_BAR;
    } else {
        PG8_STAGE(PG8_SB(0, 0), cB, voffB); PG8_STAGE(PG8_SA(0, 0), cA, voffA); PG8_STAGE(PG8_SB(0, 1), cB + hstepB, voffB); PG8_STAGE(PG8_SA(0, 1), cA + hstepA, voffA);
        if (wr == 1) PG8_BAR;
        PG8_WAIT_V(4); PG8_BAR;
        PG8_STAGE(PG8_SB(1, 0), cB + kstep, voffB); PG8_STAGE(PG8_SA(1, 0), cA + kstep, voffA); PG8_STAGE(PG8_SB(1, 1), cB + hstepB + kstep, voffB);
        PG8_WAIT_V(6); PG8_BAR;
    }
    for (;;) {
        const bool has_next = S.next(ui + 1, nxt);
        const char* nA = has_next ? (const char*)g.A + (size_t)nxt.pm * tstepA + (size_t)nxt.pn * pnoffA + (size_t)nxt.kt0 * kstep : cA; const char* nB = has_next ? (const char*)g.Bt + (size_t)nxt.pn * tstepB + (size_t)nxt.kt0 * kstep : cB;
        const int nt = cur.nkt;
        for (int t = 0; t < nt; t += 2) {
            const bool last = (t == nt - 2);
            const char* a1 = cA + (size_t)(t + 1) * kstep;
            const char* a2 = last ? nA : cA + (size_t)(t + 2) * kstep; const char* b2 = last ? nB : cB + (size_t)(t + 2) * kstep;
            const char* a3 = a2 + kstep; const char* b3 = b2 + kstep;
            if (last && has_next) S.a_ready(nxt);
            if constexpr (SP2) {
            PG8_LDB(B0, 0, 0); PG8_LDB(B1, 0, 1); PG8_SCHED; PG8_LDA(At, 0, 0); PG8_STAGE(PG8_SA(1, 1), a1 + hstepA, voffA);
            PG8_WAIT_V(8); PG8_WAIT_L(0); PG8_BAR; PG8_MMA(0, 0, At, B0); PG8_MMA(0, 1, At, B1); PG8_BAR; PG8_SCHED;
            PG8_LDA(At, 0, 1); PG8_STAGE(PG8_SB(0, 0), b2, voffB); PG8_STAGE(PG8_SB(0, 1), b2 + hstepB, voffB); PG8_STAGE(PG8_SA(0, 0), a2, voffA);
            PG8_WAIT_V(8); PG8_WAIT_L(0); PG8_BAR; PG8_MMA(1, 0, At, B0); PG8_MMA(1, 1, At, B1); PG8_BAR; PG8_SCHED;
            PG8_LDB(B0, 1, 0); PG8_LDB(B1, 1, 1); PG8_SCHED; PG8_LDA(At, 1, 0); PG8_STAGE(PG8_SA(0, 1), a2 + hstepA, voffA);
            PG8_WAIT_V(8); PG8_WAIT_L(0); PG8_BAR; PG8_MMA(0, 0, At, B0); PG8_MMA(0, 1, At, B1); PG8_BAR; PG8_SCHED;
            PG8_LDA(At, 1, 1); PG8_STAGE(PG8_SB(1, 0), b3, voffB); PG8_STAGE(PG8_SB(1, 1), b3 + hstepB, voffB); PG8_STAGE(PG8_SA(1, 0), a3, voffA);
            PG8_WAIT_V(8); PG8_WAIT_L(0); PG8_BAR; PG8_MMA(1, 0, At, B0); PG8_MMA(1, 1, At, B1); PG8_BAR; PG8_SCHED;
            } else {
            PG8_LDB(B0, 0, 0); PG8_SCHED; PG8_LDA(At, 0, 0); PG8_STAGE(PG8_SA(1, 1), a1 + hstepA, voffA);
            PG8_WAIT_L(8); PG8_BAR; PG8_WAIT_L(0); PG8_MMA(0, 0, At, B0); PG8_BAR; PG8_SCHED;
            PG8_LDB(B1, 0, 1); PG8_STAGE(PG8_SB(0, 0), b2, voffB);
            PG8_BAR; PG8_WAIT_L(0); PG8_MMA(0, 1, At, B1); PG8_BAR;
            PG8_LDA(At, 0, 1); PG8_STAGE(PG8_SA(0, 0), a2, voffA);
            PG8_BAR; PG8_WAIT_L(0); PG8_MMA(1, 0, At, B0); PG8_BAR; PG8_SCHED;
            PG8_STAGE(PG8_SB(0, 1), b2 + hstepB, voffB);
            PG8_WAIT_V(6); PG8_BAR; PG8_MMA(1, 1, At, B1); PG8_BAR;
            PG8_LDB(B0, 1, 0); PG8_SCHED; PG8_LDA(At, 1, 0); PG8_STAGE(PG8_SA(0, 1), a2 + hstepA, voffA);
            PG8_WAIT_L(8); PG8_BAR; PG8_WAIT_L(0); PG8_MMA(0, 0, At, B0); PG8_BAR; PG8_SCHED;
            PG8_LDB(B1, 1, 1); PG8_STAGE(PG8_SB(1, 0), b3, voffB);
            PG8_BAR; PG8_WAIT_L(0); PG8_MMA(0, 1, At, B1); PG8_BAR;
            PG8_LDA(At, 1, 1); PG8_STAGE(PG8_SA(1, 0), a3, voffA);
            PG8_BAR; PG8_WAIT_L(0); PG8_MMA(1, 0, At, B0); PG8_BAR; PG8_SCHED;
            PG8_STAGE(PG8_SB(1, 1), b3 + hstepB, voffB);
            PG8_WAIT_V(6); PG8_BAR; PG8_MMA(1, 1, At, B1); PG8_BAR;
            }
        }
        if constexpr (ALIGN_EPI) { if (wr == 0) PG8_BAR; }
        if constexpr (!Epi::AFTER_DRAIN) { E(acc, cur, wr, wc, fr, fq); S.done(cur); }
        if (!has_next) break;
#pragma unroll
        for (int a = 0; a < 2; ++a)
#pragma unroll
            for (int b = 0; b < 2; ++b)
#pragma unroll
                for (int m = 0; m < 4; ++m)
#pragma unroll
                    for (int n = 0; n < 2; ++n) acc[a][b][m][n] = (f32x4){0.f, 0.f, 0.f, 0.f};
        cur = nxt; cA = nA; cB = nB; ++ui;
        if constexpr (ALIGN_EPI) { if (wr == 1) PG8_BAR; }
    }
    PG8_WAIT_V(0);
    if constexpr (!ALIGN_EPI) { if (wr == 0) PG8_BAR; }
    PG8_BAR;
    if constexpr (Epi::AFTER_DRAIN) { E.fused(acc, cur, wr, wc, fr, fq, lds, wid, lane); S.done(cur); }
#undef PG8_SA
#undef PG8_SB
#undef PG8_STAGE
#undef PG8_LDA
#undef PG8_LDB
#undef PG8_MMA
#undef PG8_WAIT_V
#undef PG8_WAIT_L
#undef PG8_BAR
#undef PG8_SCHED
}
}

constexpr int D = 2048, NB = 2, SEQ = 16384, DEPTH = 2, GRID_W = 64, GRID_R = 256, CTXL = 256;
constexpr int HW = 1024, PW = 1024, HD = 128, NH = 8, DFF = 5632, NMOD = 9, INW = 6144;
constexpr int ML = NB * SEQ, MC = NB * CTXL, M = ML + MC;
constexpr int NSC = 33, SCT = 512;
constexpr float EPS = 1e-6f;
constexpr int NWAVES = 8, NTHR = 512;

constexpr size_t MiB = 1u << 20;
constexpr size_t WS_CTL = 0, ZERO_BYTES = 1 * MiB;
constexpr size_t WS_MOD = 2 * MiB + 65536;
constexpr size_t WS_LBV = 2 * MiB, WS_CTXS = 3 * MiB;
constexpr size_t WS_W1T = 8 * MiB, W1T_SZ = (size_t)2 * DFF * D * 2;
constexpr size_t WS_W2T = WS_W1T + 4 * W1T_SZ, W2T_SZ = (size_t)D * DFF * 2;
constexpr size_t WS_WINT = WS_W2T + 4 * W2T_SZ, WINT_SZ = (size_t)INW * D * 2;
constexpr size_t WS_WOT = WS_WINT + 2 * WINT_SZ, WOT_SZ = (size_t)D * D * 2;
constexpr size_t WS_WPT = WS_WOT + 2 * WOT_SZ, WPT_SZ = (size_t)PW * 256 * 2;
constexpr size_t WS_ABUF = 338 * MiB;
constexpr size_t WS_MIX = 468 * MiB;
constexpr size_t WS_HBUF = 598 * MiB;
constexpr size_t WS_YBUF = 988 * MiB;
constexpr size_t WS_HST = WS_YBUF + 65 * MiB;
constexpr size_t WS_XS = 1118 * MiB;
constexpr size_t WS_HSTC = 1374 * MiB;
constexpr size_t WS_PD = 1376 * MiB;
constexpr size_t WS_YP = 1377 * MiB;
constexpr size_t WS_END = 1393 * MiB;
static_assert(WS_WPT + 2 * WPT_SZ <= WS_ABUF && WS_ABUF + (size_t)M * D * 2 <= WS_MIX && WS_HBUF + (size_t)M * INW * 2 <= WS_YBUF && WS_YBUF + (size_t)M * D * 2 <= WS_XS, "ws map");
static_assert(WS_HST + (size_t)16 * 2 * 32 * 128 * 128 * 4 <= WS_XS && WS_XS + (size_t)ML * D * 4 <= WS_HSTC, "ws map 2");
constexpr int CW_TMO = 0, CW_BAR = 4096;

constexpr int RING_BYTES = 131072, LDSCTL_OFF = RING_BYTES, MISC_OFF = LDSCTL_OFF + 320, LDS_BYTES = 147456;

#define GAS __attribute__((address_space(1)))
#define LAS __attribute__((address_space(3)))
typedef unsigned short bf16;
typedef unsigned v4u __attribute__((ext_vector_type(4)));
typedef unsigned v2u __attribute__((ext_vector_type(2)));
typedef float f32x4 __attribute__((ext_vector_type(4)));
typedef float f32x2 __attribute__((ext_vector_type(2)));
typedef GAS unsigned gu32;
#define RLX_AGENT __ATOMIC_RELAXED, __HIP_MEMORY_SCOPE_AGENT
#define LDS_WAIT() asm volatile("s_waitcnt lgkmcnt(0)" ::: "memory")
#define VM_WAIT() asm volatile("s_waitcnt vmcnt(0)" ::: "memory")
__device__ __forceinline__ unsigned f2bf(float f) { unsigned u = __builtin_bit_cast(unsigned, f); return (u + 0x7fffu + ((u >> 16) & 1u)) >> 16; }
__device__ __forceinline__ unsigned pk2(float lo, float hi) { return f2bf(lo) | (f2bf(hi) << 16); }
__device__ __forceinline__ float bflo(unsigned w) { return __builtin_bit_cast(float, w << 16); }
__device__ __forceinline__ float bfhi(unsigned w) { return __builtin_bit_cast(float, w & 0xffff0000u); }
__device__ __forceinline__ float sigmoidf_(float z) { return __builtin_amdgcn_rcpf(1.0f + __builtin_amdgcn_exp2f(z * -1.44269504089f)); }
template <int CTRL> __device__ __forceinline__ float dpp_f(float v) { return __builtin_bit_cast(float, __builtin_amdgcn_update_dpp(0, __builtin_bit_cast(int, v), CTRL, 0xF, 0xF, true)); }
__device__ __forceinline__ float wave_sum(float v) {
    v += dpp_f<0xB1>(v);
    v += dpp_f<0x4E>(v);
    v += dpp_f<0x141>(v);
    v += dpp_f<0x140>(v);
    const float r0 = __builtin_bit_cast(float, __builtin_amdgcn_readlane(__builtin_bit_cast(int, v), 0)), r1 = __builtin_bit_cast(float, __builtin_amdgcn_readlane(__builtin_bit_cast(int, v), 16));
    const float r2 = __builtin_bit_cast(float, __builtin_amdgcn_readlane(__builtin_bit_cast(int, v), 32)), r3 = __builtin_bit_cast(float, __builtin_amdgcn_readlane(__builtin_bit_cast(int, v), 48));
    return (r0 + r1) + (r2 + r3);
}

#define XB_TMO      128
#define XB_XCNT(j)  (256  + 64 * (j))
#define XB_XSUB(j)  (1280 + 64 * (j))
#define XB_XGEN(j)  (2304 + 64 * (j))
#define XB_TOP      3328
#define XB_TOPGEN   3392
#define XCD_BAR_WORDS 3456
#define XB_SPIN_CAP (1u << 18)

__device__ __forceinline__ unsigned xb_ld(unsigned* p)              { return __hip_atomic_load(p, __ATOMIC_RELAXED, __HIP_MEMORY_SCOPE_AGENT); }
__device__ __forceinline__ unsigned xb_add(unsigned* p, unsigned v) { return __hip_atomic_fetch_add(p, v, __ATOMIC_RELAXED, __HIP_MEMORY_SCOPE_AGENT); }
__device__ __forceinline__ unsigned xb_xcc_id() { return (unsigned)__builtin_amdgcn_s_getreg((3 << 11) | 20) & 0xFu; }
#define XB_SPIN(cond, bar) do { unsigned _sp = 0; while (cond) { __builtin_amdgcn_s_sleep(1); \
    if ((++_sp & 255u) == 0u) { if (xb_ld(&(bar)[XB_TMO])) break; if (_sp > XB_SPIN_CAP) { atomicAdd(&(bar)[XB_TMO], 1u); break; } } } } while (0)

struct XcdBarrier {
    unsigned* bar; unsigned x;
    volatile LAS unsigned* st;
};

__device__ __forceinline__ XcdBarrier xcd_barrier_post(unsigned* bar, volatile LAS unsigned* st) {
    XcdBarrier b; b.bar = bar; b.x = xb_xcc_id(); b.st = st;
    if (threadIdx.x == 0) (void)xb_add(&bar[XB_XCNT(b.x)], 1u);
    return b;
}
__device__ __forceinline__ void xcd_barrier_complete(unsigned* bar, unsigned x, unsigned& nloc, unsigned& nx) {
    const unsigned G = gridDim.x * gridDim.y * gridDim.z;
    unsigned sum, cnt, mine, sp = 0u;
    for (;;) {
        sum = 0u; cnt = 0u; mine = 0u;
#pragma unroll
        for (unsigned j = 0; j < 16; ++j) { const unsigned c = xb_ld(&bar[XB_XCNT(j)]); sum += c; cnt += (c > 0u) ? 1u : 0u; mine = (j == x) ? c : mine; }
        if (sum == G) break;
        __builtin_amdgcn_s_sleep(1);
        if ((++sp & 255u) == 0u) { if (xb_ld(&bar[XB_TMO])) break; if (sp > XB_SPIN_CAP) { atomicAdd(&bar[XB_TMO], 1u); break; } }
    }
    nloc = mine > 0u ? mine : 1u; nx = cnt > 0u ? cnt : 1u;
}

__device__ __forceinline__ void xcd_barrier(const XcdBarrier& b) {
    asm volatile("s_waitcnt vmcnt(0)" ::: "memory");
    __syncthreads();
    if (threadIdx.x == 0) {
        unsigned* bar = b.bar;
        __builtin_amdgcn_s_waitcnt(0);
        unsigned nloc = b.st[0], nx = b.st[1];
        if (nloc == 0u) { xcd_barrier_complete(bar, b.x, nloc, nx); b.st[0] = nloc; b.st[1] = nx; }
        const unsigned old = xb_add(&bar[XB_XSUB(b.x)], 1u);
        const unsigned gen = old / nloc;
        if (old + 1u == (gen + 1u) * nloc) {
            __builtin_amdgcn_fence(__ATOMIC_RELEASE, "agent");
            asm volatile("s_waitcnt vmcnt(0)" ::: "memory");
            const unsigned og = xb_add(&bar[XB_TOP], 1u);
            const unsigned tg = og / nx;
            if (og + 1u == (tg + 1u) * nx) xb_add(&bar[XB_TOPGEN], 1u);
            else XB_SPIN(xb_ld(&bar[XB_TOPGEN]) == tg, bar);
            __builtin_amdgcn_fence(__ATOMIC_ACQUIRE, "agent");
            xb_add(&bar[XB_XGEN(b.x)], 1u);
            asm volatile("s_waitcnt vmcnt(0)" ::: "memory");
        } else {
            XB_SPIN(xb_ld(&bar[XB_XGEN(b.x)]) == gen, bar);
            __builtin_amdgcn_fence(__ATOMIC_ACQUIRE, "agent");
            asm volatile("s_waitcnt vmcnt(0)" ::: "memory");
        }
    }
    __syncthreads();
}


struct Frame {
    LAS unsigned char* lds;
    int tid, lane, wave, vcu, G;
};

__device__ __forceinline__ void transpose_load(const float* W, int N, int k0, int n0, int lane, float (&r)[32]) {
#pragma unroll
    for (int i = 0; i < 32; ++i) { const int kk = 2 * i + (lane >> 5); r[i] = __builtin_nontemporal_load(W + (size_t)(k0 + kk) * N + n0 + (lane & 31)); }
}
__device__ __forceinline__ void transpose_store(const float (&r)[32], bf16* WT, int ldt, int k0, int drow0, LAS float* scr, int lane) {
#pragma unroll
    for (int i = 0; i < 32; ++i) { const int kk = 2 * i + (lane >> 5); scr[kk * 33 + (lane & 31)] = r[i]; }
    LDS_WAIT(); asm volatile("" ::: "memory");
    const int c = lane & 7;
#pragma unroll
    for (int j = 0; j < 4; ++j) { const int n = (lane >> 3) + 8 * j; const LAS float* s = scr + (8 * c) * 33 + n;
        v4u o; o.x = pk2(s[0 * 33], s[1 * 33]); o.y = pk2(s[2 * 33], s[3 * 33]); o.z = pk2(s[4 * 33], s[5 * 33]); o.w = pk2(s[6 * 33], s[7 * 33]);
        *(GAS v4u*)(WT + (size_t)(drow0 + n) * ldt + k0 + 8 * c) = o; }
    LDS_WAIT(); asm volatile("" ::: "memory");
}
__device__ __forceinline__ void transpose_decode(const float* const* in, unsigned char* ws, int it, const float*& W, int& N, bf16*& WT, int& ldt, int& k0, int& n0, int& drow0) {
    constexpr int I1 = (D / 64) * (2 * DFF / 32), I2 = (DFF / 64) * (D / 32), IIN = (D / 64) * (INW / 32), IOUT = (D / 64) * (D / 32), IP = (256 / 64) * (256 / 32);
    constexpr int IL = 2 * I1 + 2 * I2 + IIN + IOUT + 4 * IP;
    const int l = it / IL; int r = it % IL;
    if (r < 2 * I1) { const int j = r / I1; r %= I1; const int nblk = 2 * DFF / 32, kb = r / nblk, nb = r % nblk; n0 = nb * 32; k0 = kb * 64;
        drow0 = n0 < DFF ? 256 * (n0 / 128) + (n0 % 128) : 256 * ((n0 - DFF) / 128) + 128 + ((n0 - DFF) % 128);
        W = in[7] + (size_t)(l * 2 + j) * D * 2 * DFF; N = 2 * DFF; WT = (bf16*)(ws + WS_W1T + (size_t)(l * 2 + j) * W1T_SZ); ldt = D; return; }
    r -= 2 * I1;
    if (r < 2 * I2) { const int j = r / I2; r %= I2; const int nblk = D / 32, kb = r / nblk, nb = r % nblk; n0 = nb * 32; k0 = kb * 64; drow0 = n0;
        W = in[8] + (size_t)(l * 2 + j) * DFF * D; N = D; WT = (bf16*)(ws + WS_W2T + (size_t)(l * 2 + j) * W2T_SZ); ldt = DFF; return; }
    r -= 2 * I2;
    if (r < IIN) { const int nblk = INW / 32, kb = r / nblk, nb = r % nblk; n0 = nb * 32; k0 = kb * 64; drow0 = n0;
        W = in[9] + (size_t)l * D * INW; N = INW; WT = (bf16*)(ws + WS_WINT + (size_t)l * WINT_SZ); ldt = D; return; }
    r -= IIN;
    if (r < IOUT) { const int nblk = D / 32, kb = r / nblk, nb = r % nblk; n0 = nb * 32; k0 = kb * 64; drow0 = n0;
        W = in[15] + (size_t)l * D * D; N = D; WT = (bf16*)(ws + WS_WOT + (size_t)l * WOT_SZ); ldt = D; return; }
    r -= IOUT;
    { const int g = r / IP; r %= IP; const int nblk = 256 / 32, kb = r / nblk, nb = r % nblk; n0 = nb * 32; k0 = kb * 64; drow0 = g * 256 + n0;
        W = in[12] + (size_t)(l * 4 + g) * 256 * 256; N = 256; WT = (bf16*)(ws + WS_WPT + (size_t)l * WPT_SZ); ldt = 256; }
}
__device__ __forceinline__ void weight_copy(const Frame& F, const float* const* in, unsigned char* ws, int it0, int it1, int gw, int NGW) {
    LAS float* scr = (LAS float*)(F.lds + F.wave * 16384);
    int it = it0 + gw;
    if (it < it1) {
        const float* W; bf16* WT; int N, ldt, k0, n0, drow0; float r[32];
        transpose_decode(in, ws, it, W, N, WT, ldt, k0, n0, drow0); transpose_load(W, N, k0, n0, F.lane, r);
        for (;;) {
            const int itn = it + NGW; const bool more = itn < it1;
            const float* Wn = W; bf16* WTn = WT; int Nn = N, ldtn = ldt, k0n = k0, n0n = n0, drow0n = drow0; float rn[32];
            if (more) { transpose_decode(in, ws, itn, Wn, Nn, WTn, ldtn, k0n, n0n, drow0n); transpose_load(Wn, Nn, k0n, n0n, F.lane, rn); }
            transpose_store(r, WT, ldt, k0, drow0, scr, F.lane);
            if (!more) break;
            it = itn; W = Wn; WT = WTn; N = Nn; ldt = ldtn; k0 = k0n; n0 = n0n; drow0 = drow0n;
#pragma unroll
            for (int i = 0; i < 32; ++i) r[i] = rn[i];
        }
    }
}
constexpr int WC_IL = 2 * (D / 64) * (2 * DFF / 32) + 2 * (DFF / 64) * (D / 32) + (D / 64) * (INW / 32) + (D / 64) * (D / 32) + 4 * (256 / 64) * (256 / 32);
__device__ __forceinline__ void p0_prologue(const Frame& F, const float* const* in, unsigned char* ws) {
    const float* c_in = in[1]; const float* cctx = in[3]; const float* w_ada = in[4]; const float* b_ada = in[5];
    float* MOD = (float*)(ws + WS_MOD);
    LAS float* sv = (LAS float*)F.lds;
    LAS f32x4* part = (LAS f32x4*)(F.lds + 32768);
    for (int i = F.tid; i < 3 * D; i += NTHR) { const int r = i / D, k = i % D; const float v = r < 2 ? c_in[r * D + k] : cctx[k]; sv[i] = v * sigmoidf_(v); }
    __syncthreads();
    {
        constexpr int NV4 = NMOD * D / 4;
        for (int wi = F.vcu; wi < DEPTH * NV4 / 64; wi += F.G) {
            const int cg = wi * 64 + F.lane, l = cg / NV4, n4 = cg % NV4, kc = F.wave;
            const float* w = w_ada + ((size_t)l * D + kc * 256) * (NMOD * D) + n4 * 4;
            f32x4 a0 = {0.f, 0.f, 0.f, 0.f}, a1 = a0, a2 = a0;
#pragma unroll 8
            for (int k = 0; k < 256; ++k) { const f32x4 wv = __builtin_nontemporal_load((const GAS f32x4*)(w + (size_t)k * (NMOD * D)));
                a0 += sv[kc * 256 + k] * wv; a1 += sv[D + kc * 256 + k] * wv; a2 += sv[2 * D + kc * 256 + k] * wv; }
            part[(F.wave * 3 + 0) * 64 + F.lane] = a0; part[(F.wave * 3 + 1) * 64 + F.lane] = a1; part[(F.wave * 3 + 2) * 64 + F.lane] = a2;
            __syncthreads();
            if (F.wave < 3) { const int r = F.wave; f32x4 s = *(const GAS f32x4*)(b_ada + (size_t)l * NMOD * D + n4 * 4);
#pragma unroll
                for (int w8 = 0; w8 < 8; ++w8) s += part[(w8 * 3 + r) * 64 + F.lane];
                *(GAS f32x4*)(MOD + ((size_t)l * 3 + r) * NMOD * D + n4 * 4) = s; }
            __syncthreads();
        }
        const int gtid = F.vcu * NTHR + F.tid;
        if (gtid < 2 * HW) { const float* lbin = in[10]; float* LBV = (float*)(ws + WS_LBV);
            float a[DEPTH], mx = -3.0e38f, s = 0.f;
#pragma unroll
            for (int l = 0; l < DEPTH; ++l) { a[l] = lbin[l * 2 * HW + gtid]; mx = fmaxf(mx, a[l]); }
#pragma unroll
            for (int l = 0; l < DEPTH; ++l) { a[l] = __expf(a[l] - mx); s += a[l]; }
            float cum = 0.f; const float p0 = a[0] / s;
#pragma unroll
            for (int l = 0; l < DEPTH; ++l) { cum += a[l] / s; LBV[l * 2 * HW + gtid] = cum - p0; } }
    }
    __syncthreads();
    weight_copy(F, in, ws, 0, F.G == 256 ? WC_IL : DEPTH * WC_IL, F.vcu * NWAVES + F.wave, F.G * NWAVES);
}

struct NormP {
    const void* xin_l; const void* xin_c; void* xout_l; void* xout_c; const bf16* Y; bf16* A;
    const float* modR; const float* gainsR;
    const float* modA; const float* gainsA;
    const float* YP;
    int gateIdx, gain1Idx, gain2Idx, shiftIdx, scaleIdx, coefHalf;
};
typedef __amdgpu_buffer_rsrc_t rsrc_t;
__device__ __forceinline__ rsrc_t mk_rsrc(const void* p, unsigned bytes) { return __builtin_amdgcn_make_buffer_rsrc((void*)p, 0, bytes, 0x00020000); }
__device__ __forceinline__ f32x4 bld4(rsrc_t r, int voff, int soff) { return __builtin_bit_cast(f32x4, __builtin_amdgcn_raw_buffer_load_b128(r, voff, soff, 0)); }
__device__ __forceinline__ v4u bld4u(rsrc_t r, int voff, int soff) { return __builtin_bit_cast(v4u, __builtin_amdgcn_raw_buffer_load_b128(r, voff, soff, 0)); }
__device__ __forceinline__ v2u bld2u(rsrc_t r, int voff, int soff) { return __builtin_bit_cast(v2u, __builtin_amdgcn_raw_buffer_load_b64(r, voff, soff, 0)); }
__device__ __forceinline__ void bst4(f32x4 v, rsrc_t r, int voff, int soff) { __builtin_amdgcn_raw_buffer_store_b128(__builtin_bit_cast(v4u, v), r, voff, soff, 0); }
__device__ __forceinline__ void bst4u(v4u v, rsrc_t r, int voff, int soff) { __builtin_amdgcn_raw_buffer_store_b128(v, r, voff, soff, 0); }
__device__ __forceinline__ void bst2u(v2u v, rsrc_t r, int voff, int soff) { __builtin_amdgcn_raw_buffer_store_b64(v, r, voff, soff, 0); }
template <bool HAS_Y, bool HAS_A, bool YSPLIT, bool XIN16, bool XOUT16>
__device__ __forceinline__ void norm_rows(const Frame& F, const NormP P, int row0, int nrows, int r) {
    f32x4 cA[8], cB[8], cC[8];
    if (HAS_Y) { const GAS f32x4* g = (const GAS f32x4*)(P.modR + (size_t)(r * NMOD + P.gateIdx) * D) + F.lane; const GAS f32x4* n = (const GAS f32x4*)(P.gainsR + (size_t)P.gain1Idx * D) + F.lane;
        const float coef = P.coefHalf ? 0.5f : 1.0f;
#pragma unroll
        for (int j = 0; j < 8; ++j) cA[j] = coef * g[64 * j] * n[64 * j]; }
    if (HAS_A) { const GAS f32x4* n = (const GAS f32x4*)(P.gainsA + (size_t)P.gain2Idx * D) + F.lane; const GAS f32x4* sc = (const GAS f32x4*)(P.modA + (size_t)(r * NMOD + P.scaleIdx) * D) + F.lane;
        const GAS f32x4* sh = (const GAS f32x4*)(P.modA + (size_t)(r * NMOD + P.shiftIdx) * D) + F.lane;
#pragma unroll
        for (int j = 0; j < 8; ++j) { cB[j] = n[64 * j] * (1.0f + sc[64 * j]); cC[j] = sh[64 * j]; } }
    constexpr bool PF = XIN16 && HAS_Y && !YSPLIT;
    v2u xq[8], yq[8];
    if (PF) { const bf16* xp = row0 < ML ? (const bf16*)P.xin_l + (size_t)row0 * D : (const bf16*)P.xin_c + (size_t)(row0 - ML) * D; const GAS v2u* xr = (const GAS v2u*)xp + F.lane; const GAS v2u* yr = (const GAS v2u*)(P.Y + (size_t)row0 * D) + F.lane;
#pragma unroll
        for (int j = 0; j < 8; ++j) { xq[j] = __builtin_nontemporal_load(xr + 64 * j); yq[j] = __builtin_nontemporal_load(yr + 64 * j); } }
#pragma unroll 1
    for (int row = row0; row < row0 + nrows; ++row) {
        f32x4 x[8];
        if (PF) {
#pragma unroll
            for (int j = 0; j < 8; ++j) asm volatile("" : "+v"(xq[j].x), "+v"(xq[j].y), "+v"(yq[j].x), "+v"(yq[j].y));
#pragma unroll
            for (int j = 0; j < 8; ++j) x[j] = (f32x4){bflo(xq[j].x), bfhi(xq[j].x), bflo(xq[j].y), bfhi(xq[j].y)};
            if (row + 1 < row0 + nrows) { const int rn = row + 1; const bf16* xp = rn < ML ? (const bf16*)P.xin_l + (size_t)rn * D : (const bf16*)P.xin_c + (size_t)(rn - ML) * D; const GAS v2u* xr = (const GAS v2u*)xp + F.lane;
#pragma unroll
                for (int j = 0; j < 8; ++j) xq[j] = __builtin_nontemporal_load(xr + 64 * j); } }
        else if (XIN16) { const bf16* xp = row < ML ? (const bf16*)P.xin_l + (size_t)row * D : (const bf16*)P.xin_c + (size_t)(row - ML) * D; const GAS v2u* xr = (const GAS v2u*)xp + F.lane;
#pragma unroll
            for (int j = 0; j < 8; ++j) { const v2u w = __builtin_nontemporal_load(xr + 64 * j); x[j] = (f32x4){bflo(w.x), bfhi(w.x), bflo(w.y), bfhi(w.y)}; } }
        else { const float* xp = row < ML ? (const float*)P.xin_l + (size_t)row * D : (const float*)P.xin_c + (size_t)(row - ML) * D; const GAS f32x4* xr = (const GAS f32x4*)xp + F.lane;
#pragma unroll
            for (int j = 0; j < 8; ++j) x[j] = __builtin_nontemporal_load(xr + 64 * j); }
        if (HAS_Y && PF) {
            float ss = 0.f;
#pragma unroll
            for (int j = 0; j < 8; ++j) { const float a0 = bflo(yq[j].x), a1 = bfhi(yq[j].x), a2 = bflo(yq[j].y), a3 = bfhi(yq[j].y); ss += (a0 * a0 + a1 * a1) + (a2 * a2 + a3 * a3); }
            const float rinv = rsqrtf(wave_sum(ss) * (1.0f / D) + EPS);
#pragma unroll
            for (int j = 0; j < 8; ++j) { const f32x4 yv = {bflo(yq[j].x), bfhi(yq[j].x), bflo(yq[j].y), bfhi(yq[j].y)}; x[j] += cA[j] * (yv * rinv); }
            if (row + 1 < row0 + nrows) { const GAS v2u* yr = (const GAS v2u*)(P.Y + (size_t)(row + 1) * D) + F.lane;
#pragma unroll
                for (int j = 0; j < 8; ++j) yq[j] = __builtin_nontemporal_load(yr + 64 * j); }
            if (XOUT16) { bf16* xo = row < ML ? (bf16*)P.xout_l + (size_t)row * D : (bf16*)P.xout_c + (size_t)(row - ML) * D; GAS v2u* xw = (GAS v2u*)xo + F.lane;
#pragma unroll
                for (int j = 0; j < 8; ++j) { v2u w; w.x = pk2(x[j].x, x[j].y); w.y = pk2(x[j].z, x[j].w); __builtin_nontemporal_store(w, xw + 64 * j); x[j] = (f32x4){bflo(w.x), bfhi(w.x), bflo(w.y), bfhi(w.y)}; } }
            else { float* xo = row < ML ? (float*)P.xout_l + (size_t)row * D : (float*)P.xout_c + (size_t)(row - ML) * D; GAS f32x4* xw = (GAS f32x4*)xo + F.lane;
#pragma unroll
                for (int j = 0; j < 8; ++j) __builtin_nontemporal_store(x[j], xw + 64 * j); }
        }
        else if (HAS_Y) {
            f32x4 y[8]; float ss = 0.f;
            if (YSPLIT) { const GAS f32x4* yp = (const GAS f32x4*)(P.YP + (size_t)(row - ML) * D) + F.lane;
#pragma unroll
                for (int j = 0; j < 8; ++j) { y[j] = (yp[64 * j] + yp[64 * j + (size_t)MC * D / 4]) + (yp[64 * j + 2 * (size_t)MC * D / 4] + yp[64 * j + 3 * (size_t)MC * D / 4]); } }
            else { const GAS v2u* yr = (const GAS v2u*)(P.Y + (size_t)row * D) + F.lane;
#pragma unroll
                for (int j = 0; j < 8; ++j) { const v2u yw = __builtin_nontemporal_load(yr + 64 * j); y[j] = (f32x4){bflo(yw.x), bfhi(yw.x), bflo(yw.y), bfhi(yw.y)}; } }
#pragma unroll
            for (int j = 0; j < 8; ++j) ss += (y[j].x * y[j].x + y[j].y * y[j].y) + (y[j].z * y[j].z + y[j].w * y[j].w);
            const float rinv = rsqrtf(wave_sum(ss) * (1.0f / D) + EPS);
            if (XOUT16) { bf16* xo = row < ML ? (bf16*)P.xout_l + (size_t)row * D : (bf16*)P.xout_c + (size_t)(row - ML) * D; GAS v2u* xw = (GAS v2u*)xo + F.lane;
#pragma unroll
                for (int j = 0; j < 8; ++j) { x[j] += cA[j] * (y[j] * rinv); v2u w; w.x = pk2(x[j].x, x[j].y); w.y = pk2(x[j].z, x[j].w); __builtin_nontemporal_store(w, xw + 64 * j);
                    x[j] = (f32x4){bflo(w.x), bfhi(w.x), bflo(w.y), bfhi(w.y)}; } }
            else { float* xo = row < ML ? (float*)P.xout_l + (size_t)row * D : (float*)P.xout_c + (size_t)(row - ML) * D; GAS f32x4* xw = (GAS f32x4*)xo + F.lane;
#pragma unroll
                for (int j = 0; j < 8; ++j) { x[j] += cA[j] * (y[j] * rinv); __builtin_nontemporal_store(x[j], xw + 64 * j); } }
        }
        if (HAS_A) {
            float ss = 0.f;
#pragma unroll
            for (int j = 0; j < 8; ++j) ss += (x[j].x * x[j].x + x[j].y * x[j].y) + (x[j].z * x[j].z + x[j].w * x[j].w);
            const float rinv = rsqrtf(wave_sum(ss) * (1.0f / D) + EPS);
            GAS v2u* aw = (GAS v2u*)(P.A + (size_t)row * D) + F.lane;
#pragma unroll
            for (int j = 0; j < 8; ++j) { const f32x4 a = (x[j] * rinv) * cB[j] + cC[j]; v2u w; w.x = pk2(a.x, a.y); w.y = pk2(a.z, a.w); aw[64 * j] = w; }
        }
    }
}
template <bool HAS_Y, bool HAS_A, bool XIN16, bool XOUT16>
__device__ __forceinline__ void norm_phase(const Frame& F, const NormP P, bool do_ctx) {
    const int gw = F.vcu * NWAVES + F.wave, NGW = F.G * NWAVES;
    constexpr int RPW = 16;
    for (int it = gw; it < ML / RPW; it += NGW) norm_rows<HAS_Y, HAS_A, false, XIN16, XOUT16>(F, P, it * RPW, RPW, (it * RPW) / SEQ);
    if (do_ctx) for (int it = gw; it < MC; it += NGW) norm_rows<HAS_Y, HAS_A, HAS_Y, XIN16, XOUT16>(F, P, ML + it, 1, 2);
}

__device__ __forceinline__ float* hst_slot(unsigned char* ws, int bd, int sc) { return sc < 32 ? (float*)(ws + WS_HST) + ((size_t)bd * 32 + sc) * (HD * HD) : (float*)(ws + WS_HSTC) + (size_t)bd * (HD * HD); }
__device__ __forceinline__ int hst_k_of(int e) { return 16 * (e >> 11) + 4 * ((e >> 6) & 3) + (e & 3); }
constexpr int HC = 16, HROW = 272;
constexpr int HL_QH = 0, HL_KH = 16 * HROW, HL_KT = 32 * HROW, HL_VT = HL_KT + 4096, HL_P7 = HL_VT + 4096, HL_UP = HL_P7 + 512, HL_BUF = HL_UP + 512;
constexpr int HL_O = 2 * HL_BUF, HOROW = 132;
constexpr int HL_ST = 45056, HG_GRP_BYTES = 45056 + 12288;
static_assert(HL_O + 16 * HOROW * 4 <= HG_GRP_BYTES && 2 * HG_GRP_BYTES <= RING_BYTES, "hgrn LDS map");
typedef short bf16x8_t __attribute__((ext_vector_type(8)));
typedef __bf16 bf16n2_t __attribute__((ext_vector_type(2)));
__device__ __forceinline__ unsigned cvtpk(float lo, float hi) { const f32x2 v = {lo, hi}; return __builtin_bit_cast(unsigned, __builtin_convertvector(v, bf16n2_t)); }
__device__ __forceinline__ void unpack8(const v4u w, float (&o)[8]) { o[0] = bflo(w.x); o[1] = bfhi(w.x); o[2] = bflo(w.y); o[3] = bfhi(w.y); o[4] = bflo(w.z); o[5] = bfhi(w.z); o[6] = bflo(w.w); o[7] = bfhi(w.w); }
__device__ __forceinline__ void hgrn_item_geom(int sc, int b, int& row0, int& ntok) { if (sc == 32) { row0 = ML + b * CTXL; ntok = CTXL; } else { row0 = b * SEQ + sc * SCT; ntok = SCT; } }

template <bool OUT, int DIR>
__device__ __forceinline__ void hgrn_run(const Frame& F, const bf16* QF, const float* LBVl, unsigned char* ws, float* PD, float* OFW, bf16* MIX, const float* hgain, int bh, int sc, int nchunk) {
    constexpr int dir = DIR;
    const int grp = F.wave >> 2, w = F.wave & 3, tg = F.tid & 255, lane = F.lane, n = lane & 15, g = lane >> 4;
    LAS unsigned char* L = F.lds + grp * HG_GRP_BYTES;
    const int b = bh >> 3, h = bh & 7; int row0, ntok; hgrn_item_geom(sc, b, row0, ntok);
    const int bd = bh * 2 + dir;
    float* slot = hst_slot(ws, bd, sc);
    f32x4 acc[8][2];
#pragma unroll
    for (int kb = 0; kb < 8; ++kb)
#pragma unroll
        for (int vb = 0; vb < 2; ++vb) acc[kb][vb] = (OUT && sc < 32) ? *(const GAS f32x4*)(slot + ((kb * 8 + 2 * w + vb) * 64 + lane) * 4) : (f32x4){0.f, 0.f, 0.f, 0.f};
    const int k = tg & 127, hf = (F.wave & 3) >> 1;
    const float lbk = LBVl[dir * HW + h * HD + k];
    float hg0 = 0.f, hg1 = 0.f; if (OUT) { hg0 = hgain[2 * lane]; hg1 = hgain[2 * lane + 1]; }
    float Pk = 1.0f;
    static_assert(OUT, "the staging image is handed over by the two barriers of an output chunk");
    const int ts = tg >> 4, sg = tg & 15;
    LAS unsigned char* ST = L + HL_ST;
    v4u wq, wz, wv;
#define HG_LOADROWS(cc) do { const int tt_ = (cc) * HC + ts, tok_ = dir ? ntok - 1 - tt_ : tt_; const GAS v4u* pr_ = (const GAS v4u*)(QF + (size_t)(row0 + tok_) * INW + h * HD + 8 * sg); \
        wq = pr_[0]; wz = pr_[(HW * (1 + dir)) / 8]; wv = pr_[3 * HW / 8]; } while (0)
#define HG_STOREROWS() do { LAS v4u* st_ = (LAS v4u*)(ST + ts * 256 + sg * 16); st_[0] = wq; st_[256] = wz; st_[512] = wv; } while (0)
    HG_LOADROWS(0); HG_STOREROWS(); if (nchunk > 1) HG_LOADROWS(1);
    __syncthreads();
    for (int c = 0; c < nchunk; ++c) {
        LAS unsigned char* LB = L + (c & 1) * HL_BUF;
        f32x2 pf_o[4] = {{0.f, 0.f}, {0.f, 0.f}, {0.f, 0.f}, {0.f, 0.f}}; unsigned pf_g[4] = {0u, 0u, 0u, 0u};
        if (OUT && DIR) {
#pragma unroll
            for (int ii = 0; ii < 4; ++ii) { const int tt = c * HC + 4 * w + ii, tok = ntok - 1 - tt; const size_t row = (size_t)(row0 + tok);
                pf_g[ii] = __builtin_nontemporal_load((const GAS unsigned*)(QF + row * INW + 4 * HW + h * HD + 2 * lane));
                pf_o[ii] = __builtin_nontemporal_load((const GAS f32x2*)(OFW + row * HW + h * HD + 2 * lane)); } }
        unsigned rz[8], rv[8], rq[8];
#pragma unroll
        for (int j = 0; j < 8; ++j) { const LAS unsigned short* sp = (const LAS unsigned short*)(ST + (8 * hf + j) * 256) + k; rq[j] = sp[0]; rz[j] = sp[2048]; rv[j] = sp[4096]; }
        {
            float f[8], qs[8];
#pragma unroll
            for (int j = 0; j < 8; ++j) { f[j] = lbk + (1.0f - lbk) * sigmoidf_(bflo((unsigned)rz[j])); if (OUT) qs[j] = bflo((unsigned)rq[j]);
 }
            float ksc[8], qsc[8];
            if (hf == 0) { float lo = 1.0f;
#pragma unroll
                for (int j = 7; j >= 0; --j) { ksc[j] = lo; qsc[j] = __builtin_amdgcn_rcpf(fmaxf(lo, 1e-30f)); lo *= f[j]; }
                const float upp = c ? ((const LAS float*)(L + ((c & 1) ^ 1) * HL_BUF + HL_UP))[k] : 1.0f;
                ((LAS float*)(LB + HL_P7))[k] = lo * upp; }
            else { float up = 1.0f;
#pragma unroll
                for (int j = 0; j < 8; ++j) { up *= f[j]; qsc[j] = up; ksc[j] = __builtin_amdgcn_rcpf(fmaxf(up, 1e-30f)); }
                ((LAS float*)(LB + HL_UP))[k] = up; }
#pragma unroll
            for (int j = 0; j < 8; ++j) ksc[j] *= 1.0f - f[j];
            v4u kt; kt.x = cvtpk(ksc[0], ksc[1]); kt.y = cvtpk(ksc[2], ksc[3]); kt.z = cvtpk(ksc[4], ksc[5]); kt.w = cvtpk(ksc[6], ksc[7]);
            *(LAS v4u*)(LB + HL_KT + k * 32 + hf * 16) = kt;
            *(LAS v4u*)(LB + HL_VT + k * 32 + hf * 16) = (v4u){(unsigned)rv[0] | ((unsigned)rv[1] << 16), (unsigned)rv[2] | ((unsigned)rv[3] << 16), (unsigned)rv[4] | ((unsigned)rv[5] << 16), (unsigned)rv[6] | ((unsigned)rv[7] << 16)};
            if (OUT) {
#pragma unroll
                for (int j = 0; j < 8; ++j) { const unsigned kw2 = (j >> 1) == 0 ? kt.x : (j >> 1) == 1 ? kt.y : (j >> 1) == 2 ? kt.z : kt.w;
                    ((LAS unsigned short*)(LB + HL_KH + (8 * hf + j) * HROW))[k] = (unsigned short)(kw2 >> (16 * (j & 1)));
                    ((LAS unsigned short*)(LB + HL_QH + (8 * hf + j) * HROW))[k] = (unsigned short)cvtpk(qs[j] * qsc[j], 0.0f); } }
        }
        __syncthreads();
        if (c + 1 < nchunk) { HG_STOREROWS(); if (c + 2 < nchunk) HG_LOADROWS(c + 2); }
        if (!OUT && tg < 128) Pk *= ((const LAS float*)(LB + HL_P7))[tg];
        {
            f32x4 pv[8]; v2u qa[4], qb[4];
#pragma unroll
            for (int kb = 0; kb < 8; ++kb) pv[kb] = *(const LAS f32x4*)(LB + HL_P7 + (16 * kb + 4 * g) * 4);
            if (OUT) {
#pragma unroll
                for (int st = 0; st < 4; ++st) { qa[st] = *(const LAS v2u*)(LB + HL_QH + n * HROW + (32 * st + 4 * g) * 2); qb[st] = *(const LAS v2u*)(LB + HL_QH + n * HROW + (32 * st + 16 + 4 * g) * 2); } }
            __builtin_amdgcn_sched_barrier(0);
#pragma unroll
            for (int kb = 0; kb < 8; ++kb) { acc[kb][0] *= pv[kb]; acc[kb][1] *= pv[kb]; }
            bf16x8_t ka[4], qb2[4]; v2u vt[2], kt[8];
            if (OUT) {
#pragma unroll
                for (int st = 0; st < 4; ++st) { ka[st] = *(const LAS bf16x8_t*)(LB + HL_KH + n * HROW + (32 * st + 8 * g) * 2); qb2[st] = *(const LAS bf16x8_t*)(LB + HL_QH + n * HROW + (32 * st + 8 * g) * 2); } }
#pragma unroll
            for (int vb = 0; vb < 2; ++vb) vt[vb] = *(const LAS v2u*)(LB + HL_VT + (32 * w + 16 * vb + n) * 32 + g * 8);
            __builtin_amdgcn_sched_barrier(0);
            f32x4 o[2] = {{0.f, 0.f, 0.f, 0.f}, {0.f, 0.f, 0.f, 0.f}}; v4u ap = {0u, 0u, 0u, 0u};
            if (OUT) {
#pragma unroll
                for (int st = 0; st < 4; ++st) {
                    const v4u aq = {qa[st].x, qa[st].y, qb[st].x, qb[st].y};
#pragma unroll
                    for (int vb = 0; vb < 2; ++vb) { v4u bs; bs.x = cvtpk(acc[2 * st][vb][0], acc[2 * st][vb][1]); bs.y = cvtpk(acc[2 * st][vb][2], acc[2 * st][vb][3]);
                        bs.z = cvtpk(acc[2 * st + 1][vb][0], acc[2 * st + 1][vb][1]); bs.w = cvtpk(acc[2 * st + 1][vb][2], acc[2 * st + 1][vb][3]);
                        o[vb] = __builtin_amdgcn_mfma_f32_16x16x32_bf16(__builtin_bit_cast(bf16x8_t, aq), __builtin_bit_cast(bf16x8_t, bs), o[vb], 0, 0, 0); } }
                __builtin_amdgcn_sched_barrier(0);
#pragma unroll
                for (int kb = 0; kb < 8; ++kb) kt[kb] = *(const LAS v2u*)(LB + HL_KT + (16 * kb + n) * 32 + g * 8);
                __builtin_amdgcn_sched_barrier(0);
                f32x4 at = {0.f, 0.f, 0.f, 0.f};
#pragma unroll
                for (int st = 0; st < 4; ++st) at = __builtin_amdgcn_mfma_f32_16x16x32_bf16(ka[st], qb2[st], at, 0, 0, 0);
#pragma unroll
                for (int r = 0; r < 4; ++r) at[r] = (4 * g + r <= n) ? at[r] : 0.0f;
                ap.x = cvtpk(at[0], at[1]); ap.y = cvtpk(at[2], at[3]);
            }
            v4u vf[2];
#pragma unroll
            for (int vb = 0; vb < 2; ++vb) vf[vb] = (v4u){vt[vb].x, vt[vb].y, 0u, 0u};
            if (OUT) {
#pragma unroll
                for (int vb = 0; vb < 2; ++vb) o[vb] = __builtin_amdgcn_mfma_f32_16x16x32_bf16(__builtin_bit_cast(bf16x8_t, ap), __builtin_bit_cast(bf16x8_t, vf[vb]), o[vb], 0, 0, 0); }
#pragma unroll
            for (int kb = 0; kb < 8; ++kb) { const v4u kf = {kt[kb].x, kt[kb].y, 0u, 0u};
#pragma unroll
                for (int vb = 0; vb < 2; ++vb) acc[kb][vb] = __builtin_amdgcn_mfma_f32_16x16x32_bf16(__builtin_bit_cast(bf16x8_t, kf), __builtin_bit_cast(bf16x8_t, vf[vb]), acc[kb][vb], 0, 0, 0); }
            if (OUT) {
#pragma unroll
                for (int vb = 0; vb < 2; ++vb)
#pragma unroll
                    for (int r = 0; r < 4; ++r) ((LAS float*)(L + HL_O))[(4 * g + r) * HOROW + 32 * w + 16 * vb + n] = o[vb][r]; }
        }
        if (OUT) {
            __syncthreads();
#pragma unroll
            for (int ii = 0; ii < 4; ++ii) { const int ti = 4 * w + ii, tt = c * HC + ti, tok = dir ? ntok - 1 - tt : tt; const size_t row = (size_t)(row0 + tok);
                const f32x2 ov = *(const LAS f32x2*)(L + HL_O + (ti * HOROW + 2 * lane) * 4); float o0 = ov.x, o1 = ov.y;
                if (dir == 0) __builtin_nontemporal_store(ov, (GAS f32x2*)(OFW + row * HW + h * HD + 2 * lane));
                else { o0 += pf_o[ii].x; o1 += pf_o[ii].y;
                    const float rinv = rsqrtf(wave_sum(o0 * o0 + o1 * o1) * (1.0f / HD) + EPS);
                    const float g0 = bflo(pf_g[ii]), g1 = bfhi(pf_g[ii]);
                    *(GAS unsigned*)(MIX + row * D + h * HD + 2 * lane) = f2bf(o0 * rinv * hg0 * g0) | (f2bf(o1 * rinv * hg1 * g1) << 16); } }
        }
    }
    if (!OUT) {
        const LAS unsigned char* LBl = L + ((nchunk - 1) & 1) * HL_BUF;
#pragma unroll
        for (int kb = 0; kb < 8; ++kb) { const f32x4 u = *(const LAS f32x4*)(LBl + HL_UP + (16 * kb + 4 * g) * 4);
#pragma unroll
            for (int vb = 0; vb < 2; ++vb) { const f32x4 sv = acc[kb][vb] * u; const GAS f32x4* sp = (const GAS f32x4*)(slot + ((kb * 8 + 2 * w + vb) * 64 + lane) * 4);
                asm volatile("global_store_dwordx4 %0, %1, off sc1\n\ts_nop 1" :: "v"(sp), "v"(sv) : "memory"); } }
        if (tg < 128) PD[((size_t)bd * NSC + sc) * HD + tg] = Pk * ((const LAS float*)(LBl + HL_UP))[tg];
    }
}
constexpr int H2ROW = 272, H2_QH = 0, H2_KH = 32 * H2ROW, H2_PH = 4 * 32 * H2ROW - 2 * 1024 + 2 * 1024  , H2_O = 34816 + 2048, H2OROW = 132;
constexpr int H2_GRP_BYTES = 53760;
static_assert(H2_PH == 34816 && H2_O + 32 * H2OROW * 4 <= H2_GRP_BYTES && 2 * H2_GRP_BYTES <= RING_BYTES, "hgrn32 LDS map");
__device__ __forceinline__ int h2_kt(int b) { return b ? 0 : 17408; }
__device__ __forceinline__ int h2_vt(int b) { return b ? 8704 : 25600; }
template <bool OUT>
__device__ __forceinline__ void hgrn_run32(const Frame& F, const bf16* QF, const float* LBVl, unsigned char* ws, float* PD, float* OFW, bf16* MIX, const float* hgain, int bh, int sc, int dir, int nchunk) {
    const int grp = F.wave >> 2, w = F.wave & 3, tg = F.tid & 255, lane = F.lane, n = lane & 15, g = lane >> 4;
    LAS unsigned char* L = F.lds + grp * H2_GRP_BYTES;
    const int b = bh >> 3, h = bh & 7; int row0, ntok; hgrn_item_geom(sc, b, row0, ntok);
    const int bd = bh * 2 + dir;
    float* slot = hst_slot(ws, bd, sc);
    f32x4 acc[8][2];
#pragma unroll
    for (int kb = 0; kb < 8; ++kb)
#pragma unroll
        for (int vb = 0; vb < 2; ++vb) acc[kb][vb] = (OUT && sc < 32) ? *(const GAS f32x4*)(slot + ((kb * 8 + 2 * w + vb) * 64 + lane) * 4) : (f32x4){0.f, 0.f, 0.f, 0.f};
    if (OUT) VM_WAIT();
    const int k = tg & 127, hf = (F.wave & 3) >> 1;
    const float lbk = LBVl[dir * HW + h * HD + k];
    float hg0 = 0.f, hg1 = 0.f; if (OUT) { hg0 = hgain[lane]; hg1 = hgain[lane + 64]; }
    float Pk = 1.0f;
    unsigned short rz[16], rv[16], rq[16];
#pragma unroll
    for (int j = 0; j < 16; ++j) { const int tt = 16 * hf + j, tok = dir ? ntok - 1 - tt : tt; const bf16* pr = QF + (size_t)(row0 + tok) * INW + h * HD;
        rz[j] = pr[HW * (1 + dir) + k]; rv[j] = pr[3 * HW + k]; rq[j] = OUT ? pr[k] : (unsigned short)0; }
    for (int c = 0; c < nchunk; ++c) {
        const int pb_ = c & 1, ob = OUT ? 0 : pb_;
        LAS unsigned char* LKT = L + h2_kt(ob); LAS unsigned char* LVT = L + h2_vt(ob); LAS float* LPH = (LAS float*)(L + H2_PH + pb_ * 1024); LAS float* LUP = LPH + 128;
        {
            float f[16];
#pragma unroll
            for (int j = 0; j < 16; ++j) f[j] = lbk + (1.0f - lbk) * sigmoidf_(bflo((unsigned)rz[j]));
            float ksc[16], qsc[16];
            if (hf == 0) { float lo = 1.0f;
#pragma unroll
                for (int j = 15; j >= 0; --j) { ksc[j] = lo; if (OUT) qsc[j] = __builtin_amdgcn_rcpf(fmaxf(lo, 1e-30f)); lo *= f[j]; }
                const float upp = c ? ((const LAS float*)(L + H2_PH + (pb_ ^ 1) * 1024))[128 + k] : 1.0f;
                LPH[k] = lo * upp; }
            else { float up = 1.0f;
#pragma unroll
                for (int j = 0; j < 16; ++j) { up *= f[j]; if (OUT) qsc[j] = up; ksc[j] = __builtin_amdgcn_rcpf(fmaxf(up, 1e-30f)); }
                LUP[k] = up; }
#pragma unroll
            for (int j = 0; j < 16; ++j) ksc[j] *= 1.0f - f[j];
            unsigned kw[8], vw[8];
#pragma unroll
            for (int j = 0; j < 8; ++j) { kw[j] = cvtpk(ksc[2 * j], ksc[2 * j + 1]); vw[j] = (unsigned)rv[2 * j] | ((unsigned)rv[2 * j + 1] << 16); }
            *(LAS v4u*)(LKT + k * 64 + hf * 32) = (v4u){kw[0], kw[1], kw[2], kw[3]}; *(LAS v4u*)(LKT + k * 64 + hf * 32 + 16) = (v4u){kw[4], kw[5], kw[6], kw[7]};
            *(LAS v4u*)(LVT + k * 64 + hf * 32) = (v4u){vw[0], vw[1], vw[2], vw[3]}; *(LAS v4u*)(LVT + k * 64 + hf * 32 + 16) = (v4u){vw[4], vw[5], vw[6], vw[7]};
            if (OUT) {
#pragma unroll
                for (int j = 0; j < 16; ++j) { ((LAS unsigned short*)(L + H2_KH + (16 * hf + j) * H2ROW))[k] = (unsigned short)(kw[j >> 1] >> (16 * (j & 1)));
                    ((LAS unsigned short*)(L + H2_QH + (16 * hf + j) * H2ROW))[k] = (unsigned short)cvtpk(bflo((unsigned)rq[j]) * qsc[j], 0.0f); } }
        }
        if (c + 1 < nchunk) {
#pragma unroll
            for (int j = 0; j < 16; ++j) { const int tt = (c + 1) * 32 + 16 * hf + j, tok = dir ? ntok - 1 - tt : tt; const bf16* pr = QF + (size_t)(row0 + tok) * INW + h * HD;
                rz[j] = pr[HW * (1 + dir) + k]; rv[j] = pr[3 * HW + k]; if (OUT) rq[j] = pr[k]; } }
        float pf_o[8][2]; unsigned short pf_g[8][2];
        if (OUT) {
#pragma unroll
            for (int ii = 0; ii < 8; ++ii) { const int tt = c * 32 + 8 * w + ii, tok = dir ? ntok - 1 - tt : tt; const size_t row = (size_t)(row0 + tok);
                const bf16* gp = QF + row * INW + 4 * HW + h * HD; pf_g[ii][0] = gp[lane]; pf_g[ii][1] = gp[lane + 64];
                if (dir) { const float* op = OFW + row * HW + h * HD; pf_o[ii][0] = op[lane]; pf_o[ii][1] = op[lane + 64]; } else { pf_o[ii][0] = 0.f; pf_o[ii][1] = 0.f; } } }
        __syncthreads();
        if (!OUT && tg < 128) Pk *= LPH[tg];
        {
#pragma unroll
            for (int kb = 0; kb < 8; ++kb) { const f32x4 p = *(const LAS f32x4*)(LPH + 16 * kb + 4 * g); acc[kb][0] *= p; acc[kb][1] *= p; }
            f32x4 o[2][2] = {{{0.f, 0.f, 0.f, 0.f}, {0.f, 0.f, 0.f, 0.f}}, {{0.f, 0.f, 0.f, 0.f}, {0.f, 0.f, 0.f, 0.f}}};
            v4u ap[2] = {{0u, 0u, 0u, 0u}, {0u, 0u, 0u, 0u}};
            if (OUT) {
#pragma unroll
                for (int st = 0; st < 4; ++st) {
                    v4u bs[2];
#pragma unroll
                    for (int vb = 0; vb < 2; ++vb) { bs[vb].x = cvtpk(acc[2 * st][vb][0], acc[2 * st][vb][1]); bs[vb].y = cvtpk(acc[2 * st][vb][2], acc[2 * st][vb][3]);
                        bs[vb].z = cvtpk(acc[2 * st + 1][vb][0], acc[2 * st + 1][vb][1]); bs[vb].w = cvtpk(acc[2 * st + 1][vb][2], acc[2 * st + 1][vb][3]); }
#pragma unroll
                    for (int tb = 0; tb < 2; ++tb) { const LAS unsigned char* qp = L + H2_QH + (16 * tb + n) * H2ROW + (32 * st + 4 * g) * 2; const v2u qa = *(const LAS v2u*)qp, qb = *(const LAS v2u*)(qp + 32);
                        const v4u aq = {qa.x, qa.y, qb.x, qb.y};
#pragma unroll
                        for (int vb = 0; vb < 2; ++vb) o[tb][vb] = __builtin_amdgcn_mfma_f32_16x16x32_bf16(__builtin_bit_cast(bf16x8_t, aq), __builtin_bit_cast(bf16x8_t, bs[vb]), o[tb][vb], 0, 0, 0); } }
                f32x4 a00 = {0.f, 0.f, 0.f, 0.f}, a01 = a00, a11 = a00;
#pragma unroll
                for (int st = 0; st < 4; ++st) { const int ko = (32 * st + 8 * g) * 2;
                    const bf16x8_t k0 = *(const LAS bf16x8_t*)(L + H2_KH + n * H2ROW + ko), k1 = *(const LAS bf16x8_t*)(L + H2_KH + (16 + n) * H2ROW + ko);
                    const bf16x8_t q0 = *(const LAS bf16x8_t*)(L + H2_QH + n * H2ROW + ko), q1 = *(const LAS bf16x8_t*)(L + H2_QH + (16 + n) * H2ROW + ko);
                    a00 = __builtin_amdgcn_mfma_f32_16x16x32_bf16(k0, q0, a00, 0, 0, 0); a01 = __builtin_amdgcn_mfma_f32_16x16x32_bf16(k0, q1, a01, 0, 0, 0); a11 = __builtin_amdgcn_mfma_f32_16x16x32_bf16(k1, q1, a11, 0, 0, 0); }
#pragma unroll
                for (int r = 0; r < 4; ++r) { const bool keep = 4 * g + r <= n; a00[r] = keep ? a00[r] : 0.0f; a11[r] = keep ? a11[r] : 0.0f; }
                ap[0].x = cvtpk(a00[0], a00[1]); ap[0].y = cvtpk(a00[2], a00[3]);
                ap[1].x = cvtpk(a01[0], a01[1]); ap[1].y = cvtpk(a01[2], a01[3]); ap[1].z = cvtpk(a11[0], a11[1]); ap[1].w = cvtpk(a11[2], a11[3]);
            }
            v4u vf[2];
#pragma unroll
            for (int vb = 0; vb < 2; ++vb) { const LAS unsigned char* vp = LVT + (32 * w + 16 * vb + n) * 64 + g * 8; const v2u t0 = *(const LAS v2u*)vp, t1 = *(const LAS v2u*)(vp + 32); vf[vb] = (v4u){t0.x, t0.y, t1.x, t1.y}; }
            if (OUT) {
#pragma unroll
                for (int tb = 0; tb < 2; ++tb)
#pragma unroll
                    for (int vb = 0; vb < 2; ++vb) o[tb][vb] = __builtin_amdgcn_mfma_f32_16x16x32_bf16(__builtin_bit_cast(bf16x8_t, ap[tb]), __builtin_bit_cast(bf16x8_t, vf[vb]), o[tb][vb], 0, 0, 0); }
#pragma unroll
            for (int kb = 0; kb < 8; ++kb) { const LAS unsigned char* kp = LKT + (16 * kb + n) * 64 + g * 8; const v2u t0 = *(const LAS v2u*)kp, t1 = *(const LAS v2u*)(kp + 32); const v4u kf = {t0.x, t0.y, t1.x, t1.y};
#pragma unroll
                for (int vb = 0; vb < 2; ++vb) acc[kb][vb] = __builtin_amdgcn_mfma_f32_16x16x32_bf16(__builtin_bit_cast(bf16x8_t, kf), __builtin_bit_cast(bf16x8_t, vf[vb]), acc[kb][vb], 0, 0, 0); }
            if (OUT) {
#pragma unroll
                for (int tb = 0; tb < 2; ++tb)
#pragma unroll
                    for (int vb = 0; vb < 2; ++vb)
#pragma unroll
                        for (int r = 0; r < 4; ++r) ((LAS float*)(L + H2_O))[(16 * tb + 4 * g + r) * H2OROW + 32 * w + 16 * vb + n] = o[tb][vb][r]; }
        }
        if (OUT) {
            __syncthreads();
#pragma unroll
            for (int ii = 0; ii < 8; ++ii) { const int ti = 8 * w + ii, tt = c * 32 + ti, tok = dir ? ntok - 1 - tt : tt; const size_t row = (size_t)(row0 + tok);
                float o0 = ((const LAS float*)(L + H2_O))[ti * H2OROW + lane], o1 = ((const LAS float*)(L + H2_O))[ti * H2OROW + lane + 64];
                if (dir == 0) { float* op = OFW + row * HW + h * HD + lane; op[0] = o0; op[64] = o1; }
                else { o0 += pf_o[ii][0]; o1 += pf_o[ii][1];
                    const float rinv = rsqrtf(wave_sum(o0 * o0 + o1 * o1) * (1.0f / HD) + EPS);
                    const float g0 = bflo((unsigned)pf_g[ii][0]), g1 = bflo((unsigned)pf_g[ii][1]);
                    bf16* mp = MIX + row * D + h * HD + lane;
                    mp[0] = (bf16)f2bf(o0 * rinv * hg0 * g0); mp[64] = (bf16)f2bf(o1 * rinv * hg1 * g1); } }
        }
    }
    if (!OUT) {
        const LAS float* LUPl = (const LAS float*)(L + H2_PH + ((nchunk - 1) & 1) * 1024) + 128;
#pragma unroll
        for (int kb = 0; kb < 8; ++kb) { const f32x4 u = *(const LAS f32x4*)(LUPl + 16 * kb + 4 * g);
#pragma unroll
            for (int vb = 0; vb < 2; ++vb) { const f32x4 sv = acc[kb][vb] * u; const GAS f32x4* sp = (const GAS f32x4*)(slot + ((kb * 8 + 2 * w + vb) * 64 + lane) * 4);
                asm volatile("global_store_dwordx4 %0, %1, off sc1\n\ts_nop 1" :: "v"(sp), "v"(sv) : "memory"); } }
        if (tg < 128) PD[((size_t)bd * NSC + sc) * HD + tg] = Pk * LUPl[tg];
    }
}
__device__ __forceinline__ void hgrn_pass_b(const Frame& F, unsigned char* ws, const float* PD) {
    const int gtid = F.vcu * NTHR + F.tid, nthreads = F.G * NTHR;
    for (int idx = gtid; idx < 32 * HD * HD; idx += nthreads) {
        const int bd = idx >> 14, e = idx & 16383, k = hst_k_of(e), dir = bd & 1;
        float tmp[NSC], pv[NSC];
#pragma unroll
        for (int step = 0; step < NSC; ++step) { const int sc = step == 0 ? 32 : (dir == 0 ? step - 1 : 32 - step);
            tmp[step] = hst_slot(ws, bd, sc)[e]; pv[step] = PD[((size_t)bd * NSC + sc) * HD + k]; }
        float S = 0.f;
#pragma unroll
        for (int step = 0; step < NSC; ++step) { const int sc = step == 0 ? 32 : (dir == 0 ? step - 1 : 32 - step);
            hst_slot(ws, bd, sc)[e] = S; S = pv[step] * S + tmp[step]; }
    }
}

__device__ __forceinline__ void acc_bf8(float (&a)[8], const v4u w) { a[0] += bflo(w.x); a[1] += bfhi(w.x); a[2] += bflo(w.y); a[3] += bfhi(w.y); a[4] += bflo(w.z); a[5] += bfhi(w.z); a[6] += bflo(w.w); a[7] += bfhi(w.w); }
__device__ __forceinline__ void pool_v_chunk(const Frame& F, const bf16* QF, float* T, int chunk) {
    for (int u = 0; u < 16; ++u) { const int idx = (chunk * 16 + u) * NTHR + F.tid;
        const int m = idx >> 7, c8 = (idx & 127) * 8, hw = 1 << (c8 >> 8), b = m >> 14, r = (m >> 6) & 255, j = m & 63;
        const int lo = max(r - hw, 0), hi = min(r + hw, GRID_R);
        float a[8] = {0.f, 0.f, 0.f, 0.f, 0.f, 0.f, 0.f, 0.f};
        for (int rr = lo; rr < hi; ++rr) acc_bf8(a, *(const GAS v4u*)(QF + (size_t)(b * SEQ + rr * GRID_W + j) * INW + 5 * HW + c8));
        const float inv = 1.0f / (float)(hi - lo);
        *(GAS f32x4*)(T + (size_t)m * PW + c8) = (f32x4){a[0] * inv, a[1] * inv, a[2] * inv, a[3] * inv}; *(GAS f32x4*)(T + (size_t)m * PW + c8 + 4) = (f32x4){a[4] * inv, a[5] * inv, a[6] * inv, a[7] * inv}; }
}
__device__ __forceinline__ void pool_h_chunk(const Frame& F, const bf16* QF, const float* T, bf16* Dp, int chunk) {
    for (int u = 0; u < 16; ++u) { const int idx = (chunk * 16 + u) * NTHR + F.tid; if (idx >= M * 128) break;
        const int m = idx >> 7, c8 = (idx & 127) * 8, hw = 1 << (c8 >> 8);
        float a[8] = {0.f, 0.f, 0.f, 0.f, 0.f, 0.f, 0.f, 0.f}; float inv;
        if (m < ML) { const int j = m & 63, lo = max(j - hw, 0), hi = min(j + hw, GRID_W); const float* tp = T + (size_t)(m - j) * PW + c8;
            for (int jj = lo; jj < hi; ++jj) { const f32x4 t0 = *(const GAS f32x4*)(tp + (size_t)jj * PW), t1 = *(const GAS f32x4*)(tp + (size_t)jj * PW + 4);
                a[0] += t0.x; a[1] += t0.y; a[2] += t0.z; a[3] += t0.w; a[4] += t1.x; a[5] += t1.y; a[6] += t1.z; a[7] += t1.w; }
            inv = 1.0f / (float)(hi - lo); }
        else { const int t = (m - ML) & 255, lo = max(t - hw, 0), hi = min(t + hw, CTXL); const bf16* pp = QF + (size_t)(m - t) * INW + 5 * HW + c8;
            for (int tt = lo; tt < hi; ++tt) acc_bf8(a, *(const GAS v4u*)(pp + (size_t)tt * INW));
            inv = 1.0f / (float)(hi - lo); }
        const v4u pv = *(const GAS v4u*)(QF + (size_t)m * INW + 5 * HW + c8);
        v4u o; o.x = pk2(a[0] * inv - bflo(pv.x), a[1] * inv - bfhi(pv.x)); o.y = pk2(a[2] * inv - bflo(pv.y), a[3] * inv - bfhi(pv.y));
        o.z = pk2(a[4] * inv - bflo(pv.z), a[5] * inv - bfhi(pv.z)); o.w = pk2(a[6] * inv - bflo(pv.w), a[7] * inv - bfhi(pv.w));
        *(GAS v4u*)(Dp + (size_t)m * PW + c8) = o; }
}

__device__ __forceinline__ void pool_fused_item(const Frame& F, const bf16* QF, bf16* Dp, int item) {
    const int rs = item & 7, cb = (item >> 3) & 3, g = (item >> 5) & 3, b = item >> 7, hw = 1 << g, r0 = rs * 32;
    const int j = F.tid >> 3, oc = F.tid & 7, ch = g * 256 + cb * 64 + oc * 8;
    const bf16* base = QF + (size_t)(b * SEQ + j) * INW + 5 * HW + ch;
    bf16* dbase = Dp + (size_t)(b * SEQ + j) * PW + ch;
    LAS float* Tl = (LAS float*)F.lds;
    float S[8] = {0.f, 0.f, 0.f, 0.f, 0.f, 0.f, 0.f, 0.f};
    for (int rr = max(r0 - hw, 0); rr < min(r0 + hw, GRID_R); ++rr) acc_bf8(S, *(const GAS v4u*)(base + (size_t)rr * 64 * INW));
    v4u cen = *(const GAS v4u*)(base + (size_t)r0 * 64 * INW);
    const int jlo = max(j - hw, 0), jhi = min(j + hw, GRID_W); const float invj = 1.0f / (float)(jhi - jlo);
    __syncthreads();
    for (int r = r0; r < r0 + 32; ++r) {
        const bool he = r + hw < GRID_R, hl = r - hw >= 0, more = r + 1 < r0 + 32;
        v4u en = {0u, 0u, 0u, 0u}, lv = en, cn = en;
        if (more) { if (he) en = *(const GAS v4u*)(base + (size_t)(r + hw) * 64 * INW); if (hl) lv = *(const GAS v4u*)(base + (size_t)(r - hw) * 64 * INW); cn = *(const GAS v4u*)(base + (size_t)(r + 1) * 64 * INW); }
        const float invr = 1.0f / (float)(min(r + hw, GRID_R) - max(r - hw, 0));
        LAS float* Tb = Tl + ((r & 1) * 64 + j) * 64 + oc * 8;
        *(LAS f32x4*)Tb = (f32x4){S[0] * invr, S[1] * invr, S[2] * invr, S[3] * invr}; *(LAS f32x4*)(Tb + 4) = (f32x4){S[4] * invr, S[5] * invr, S[6] * invr, S[7] * invr};
        __syncthreads();
        f32x4 a0 = {0.f, 0.f, 0.f, 0.f}, a1 = a0;
        for (int jj = jlo; jj < jhi; ++jj) { const LAS float* tp = Tl + ((r & 1) * 64 + jj) * 64 + oc * 8; a0 += *(const LAS f32x4*)tp; a1 += *(const LAS f32x4*)(tp + 4); }
        float cv[8]; { cv[0] = bflo(cen.x); cv[1] = bfhi(cen.x); cv[2] = bflo(cen.y); cv[3] = bfhi(cen.y); cv[4] = bflo(cen.z); cv[5] = bfhi(cen.z); cv[6] = bflo(cen.w); cv[7] = bfhi(cen.w); }
        v4u o; o.x = pk2(a0[0] * invj - cv[0], a0[1] * invj - cv[1]); o.y = pk2(a0[2] * invj - cv[2], a0[3] * invj - cv[3]); o.z = pk2(a1[0] * invj - cv[4], a1[1] * invj - cv[5]); o.w = pk2(a1[2] * invj - cv[6], a1[3] * invj - cv[7]);
        *(GAS v4u*)(dbase + (size_t)r * 64 * PW) = o;
        if (more) { if (he) acc_bf8(S, en); if (hl) { float t[8] = {0.f, 0.f, 0.f, 0.f, 0.f, 0.f, 0.f, 0.f}; acc_bf8(t, lv);
#pragma unroll
                for (int e = 0; e < 8; ++e) S[e] -= t[e]; } cen = cn; }
    }
    __syncthreads();
}

#ifndef MK_XS16
#define MK_XS16 1
#endif
constexpr bool XS16 = MK_XS16;
#ifndef MK_ONE_LAUNCH
#define MK_ONE_LAUNCH 1
#endif
constexpr int PH_PER_LAYER = 12, N_PHASES = 2 + DEPTH * PH_PER_LAYER;
struct Args { const float* in[16]; float* out; unsigned char* ws; int ph_lo, ph_hi; };
static_assert(sizeof(Args) == 18 * 8 + 8, "Args has no padding");

__global__ void __launch_bounds__(NTHR, 2) fwd(Args args) {
    extern __shared__ __attribute__((aligned(16))) unsigned char lds_raw[];
    Frame F;
    F.lds = (LAS unsigned char*)lds_raw;
    F.tid = threadIdx.x; F.lane = F.tid & 63; F.wave = __builtin_amdgcn_readfirstlane(F.tid >> 6);
    F.G = gridDim.x; { const int bx = blockIdx.x; F.vcu = (F.G % 8 == 0) ? (bx % 8) * (F.G / 8) + bx / 8 : bx; }
    unsigned char* ws = args.ws;
    gu32* ctl = (gu32*)(ws + WS_CTL);
    for (int u = F.tid; u < (LDS_BYTES - LDSCTL_OFF) / 4; u += NTHR) ((LAS unsigned*)(F.lds + LDSCTL_OFF))[u] = 0u;
    __syncthreads();
    const int lo = args.ph_lo, hi = args.ph_hi;
    const bool multi = (hi - lo) > 1;
    XcdBarrier bar; bar.bar = (unsigned*)(ctl + CW_BAR); bar.x = 0; bar.st = nullptr;
    if (multi) bar = xcd_barrier_post((unsigned*)(ctl + CW_BAR), (volatile LAS unsigned*)(F.lds + MISC_OFF) + 8);
#define IN(k) (lo <= (k) && (k) < hi)
static_assert(WC_IL == 42112 && DEPTH == 2, "the WC_SLOT item ranges below split the second layer's 42112 copy items");
#define WC_SLOT(a, b, ntail) do { if (F.G == 256 && l == 0 && (int)blockIdx.x >= (ntail)) { __syncthreads(); REFRESH(); weight_copy(F, args.in, ws, WC_IL + (a), WC_IL + (b), ((int)blockIdx.x - (ntail)) * NWAVES + F.wave, (256 - (ntail)) * NWAVES); } } while (0)
#define DIR_SEAM() do { VM_WAIT(); __syncthreads(); if (F.wave == 0) { __builtin_amdgcn_fence(__ATOMIC_ACQUIRE, "agent"); VM_WAIT(); } __syncthreads(); } while (0)
#define REFRESH() do { int t_ = threadIdx.x; asm volatile("" : "+v"(t_)); F.tid = t_; F.lane = t_ & 63; F.wave = __builtin_amdgcn_readfirstlane(t_ >> 6); } while (0)
#define SEAM(k) do { if (IN(k) && IN((k) + 1)) xcd_barrier(bar); } while (0)

    const float* x_in = args.in[0]; const float* ctx_in = args.in[2];
    void* xs = (void*)(ws + WS_XS); void* cs = (void*)(ws + WS_CTXS);
    const float* MOD = (const float*)(ws + WS_MOD); const float* LBV = (const float*)(ws + WS_LBV);
    bf16* ABUF = (bf16*)(ws + WS_ABUF); bf16* MIX = (bf16*)(ws + WS_MIX); bf16* HBUF = (bf16*)(ws + WS_HBUF); bf16* YBUF = (bf16*)(ws + WS_YBUF);
    float* TBUF = (float*)(ws + WS_ABUF); float* OFW = args.out; bf16* DBUF = (bf16*)(ws + WS_YBUF);
    float* PD = (float*)(ws + WS_PD); float* YP = (float*)(ws + WS_YP);

    if (IN(0)) { REFRESH(); p0_prologue(F, args.in, ws); }
    SEAM(0);
    if (IN(1)) { REFRESH(); NormP P{x_in, ctx_in, nullptr, nullptr, nullptr, ABUF, nullptr, nullptr, MOD, args.in[6], YP, 0, 0, 0, 0, 1, 0};
        norm_phase<false, true, false, XS16>(F, P, true); }
    SEAM(1);

    for (int l = 0; l < DEPTH; ++l) {
        const int pb = 2 + l * PH_PER_LAYER; const bool last = (l == DEPTH - 1);
        const float* modl = MOD + (size_t)l * 3 * NMOD * D; const float* gl = args.in[6] + (size_t)l * 6 * D;
        if (IN(pb + 0)) { REFRESH(); pg8::Gemm g{ABUF, (const bf16*)(ws + WS_W1T + (size_t)(l * 2 + 0) * W1T_SZ), D, D, D, 0}; pg8::StaticOrder S; S.init(ML, 2 * DFF, F.G, (int)blockIdx.x, D / 64, 2, 1);
            pg8::EpiSwiglu E{HBUF, DFF}; pg8::gemm_phase<pg8::EpiSwiglu, pg8::StaticOrder, true, true>(F.lds, g, S, E); WC_SLOT(0, 8843, 88); }
        SEAM(pb + 0);
        if (IN(pb + 1)) { REFRESH(); pg8::Gemm g{HBUF, (const bf16*)(ws + WS_W2T + (size_t)(l * 2 + 0) * W2T_SZ), DFF, DFF, DFF, 0}; pg8::StaticOrder S; S.init(ML, D, F.G, (int)blockIdx.x, DFF / 64, 2, 4);
            pg8::EpiBf16 E{YBUF, D, 0, nullptr, nullptr, YP, ML, (size_t)MC * D, 0u}; pg8::gemm_phase<pg8::EpiBf16, pg8::StaticOrder, true, true>(F.lds, g, S, E); WC_SLOT(8843, 15581, 64); }
        SEAM(pb + 1);
        if (IN(pb + 2)) { REFRESH();
            if (l == 0) { NormP P{x_in, ctx_in, xs, cs, YBUF, ABUF, modl, gl, modl, gl, YP, 2, 1, 2, 3, 4, 1}; norm_phase<true, true, false, XS16>(F, P, true); }
            else { NormP P{xs, cs, xs, cs, YBUF, ABUF, modl, gl, modl, gl, YP, 2, 1, 2, 3, 4, 1}; norm_phase<true, true, XS16, XS16>(F, P, true); } }
        SEAM(pb + 2);
        if (IN(pb + 3)) { REFRESH(); pg8::Gemm g{ABUF, (const bf16*)(ws + WS_WINT + (size_t)l * WINT_SZ), D, D, D, 0}; pg8::StaticOrder S; S.init(ML, INW, F.G, (int)blockIdx.x, D / 64, 2, 1);
            pg8::EpiBf16 E{HBUF, INW, 0, nullptr, nullptr, nullptr, 0, 0, 0x000F000Fu}; pg8::gemm_phase<pg8::EpiBf16, pg8::StaticOrder, true, true>(F.lds, g, S, E); WC_SLOT(15581, 26530, 48); }
        SEAM(pb + 3);
        if (IN(pb + 4)) { REFRESH();
            const int nj = (last || F.G != 256) ? (536 + F.G - 1) / F.G : 3;
            for (int j = 0; j < nj; ++j) {
                int kind = -1, idx = 0;
                const int v = F.vcu;
                if (last || F.G != 256) { const int it = v + j * F.G; if (it < 512) { kind = 0; idx = it; } else if (it < 528) { kind = 1; idx = it - 512; } else if (!last && it < 536) { kind = 2; idx = it - 528; } }
                else if (v < 8) { if (j == 0) { kind = 2; idx = v; } }
                else if (j == 0) { kind = 0; idx = v - 8; }
                else if (j == 1) { kind = 0; idx = 248 + v - 8; }
                else if (v < 24) { kind = 0; idx = 496 + v - 8; }
                else if (v < 40) { kind = 1; idx = v - 24; }
                if (kind < 0) continue;
                const int grp = F.wave >> 2;
                if (kind == 2) { const int bh = 2 * idx + grp;
                    hgrn_run<true, 0>(F, HBUF, LBV + (size_t)l * 2 * HW, ws, PD, OFW, MIX, args.in[11] + (size_t)l * HD, bh, 32, 16); DIR_SEAM();
                    hgrn_run<true, 1>(F, HBUF, LBV + (size_t)l * 2 * HW, ws, PD, OFW, MIX, args.in[11] + (size_t)l * HD, bh, 32, 16); DIR_SEAM(); }
                else { int bh, dir, sc; if (kind == 0) { sc = idx & 31; dir = (idx >> 5) & 1; bh = 2 * (idx >> 6) + grp; } else { const int r = 2 * idx + grp; sc = 32; dir = r & 1; bh = r >> 1; }
                    hgrn_run32<false>(F, HBUF, LBV + (size_t)l * 2 * HW, ws, PD, nullptr, nullptr, nullptr, bh, sc, dir, kind == 0 ? 16 : 8); __syncthreads(); }
            }
            if (F.G == 256) { const int v0 = last ? 16 : 40;
                if (F.vcu >= v0) for (int it = F.vcu - v0; it < 256; it += 256 - v0) pool_fused_item(F, HBUF, DBUF, it); } }
        SEAM(pb + 4);
        if (IN(pb + 5)) { REFRESH(); hgrn_pass_b(F, ws, PD);
            if (F.G != 256) for (int it = F.vcu; it < 256; it += F.G) pool_fused_item(F, HBUF, DBUF, it);
            for (int it = ML * 128 / (16 * NTHR) + F.vcu; it < M * 128 / (16 * NTHR); it += F.G) pool_h_chunk(F, HBUF, TBUF, DBUF, it); }
        SEAM(pb + 5);
        if (IN(pb + 6)) { REFRESH();
            for (int it = F.vcu; it < 256; it += F.G) { const int sc = it & 31, bh = 2 * (it >> 5) + (F.wave >> 2);

                hgrn_run<true, 0>(F, HBUF, LBV + (size_t)l * 2 * HW, ws, PD, OFW, MIX, args.in[11] + (size_t)l * HD, bh, sc, 32); DIR_SEAM();
                hgrn_run<true, 1>(F, HBUF, LBV + (size_t)l * 2 * HW, ws, PD, OFW, MIX, args.in[11] + (size_t)l * HD, bh, sc, 32); DIR_SEAM(); }
            __syncthreads();
            pg8::Gemm g{DBUF, (const bf16*)(ws + WS_WPT + (size_t)l * WPT_SZ), PW, 256, 256, 256}; pg8::StaticOrder S; S.init(ML, PW, F.G, (int)blockIdx.x, 256 / 64, last ? 0 : 2, 1);
            pg8::EpiBf16 E{MIX, D, HW, args.in[13] + (size_t)l * PW, args.in[14] + (size_t)l * PW, nullptr, 0, 0, 0u}; pg8::gemm_phase<pg8::EpiBf16, pg8::StaticOrder, true, true>(F.lds, g, S, E); }
        SEAM(pb + 6);
        if (IN(pb + 7)) { REFRESH(); pg8::Gemm g{MIX, (const bf16*)(ws + WS_WOT + (size_t)l * WOT_SZ), D, D, D, 0}; pg8::StaticOrder S; S.init(ML, D, F.G, (int)blockIdx.x, D / 64, last ? 0 : 2, 4);
            pg8::EpiBf16 E{YBUF, D, 0, nullptr, nullptr, YP, ML, (size_t)MC * D, 0u}; pg8::gemm_phase<pg8::EpiBf16, pg8::StaticOrder, true, true>(F.lds, g, S, E); }
        SEAM(pb + 7);
        if (IN(pb + 8)) { REFRESH(); NormP P{xs, cs, xs, cs, YBUF, ABUF, modl, gl, modl, gl, YP, 5, 3, 4, 6, 7, 0};
            norm_phase<true, true, XS16, XS16>(F, P, !last); }
        SEAM(pb + 8);
        if (IN(pb + 9)) { REFRESH(); pg8::Gemm g{ABUF, (const bf16*)(ws + WS_W1T + (size_t)(l * 2 + 1) * W1T_SZ), D, D, D, 0}; pg8::StaticOrder S; S.init(ML, 2 * DFF, F.G, (int)blockIdx.x, D / 64, last ? 0 : 2, 1);
            pg8::EpiSwiglu E{HBUF, DFF}; pg8::gemm_phase<pg8::EpiSwiglu, pg8::StaticOrder, true, true>(F.lds, g, S, E); WC_SLOT(26530, 35373, 88); }
        SEAM(pb + 9);
        if (IN(pb + 10)) { REFRESH(); pg8::Gemm g{HBUF, (const bf16*)(ws + WS_W2T + (size_t)(l * 2 + 1) * W2T_SZ), DFF, DFF, DFF, 0}; pg8::StaticOrder S; S.init(ML, D, F.G, (int)blockIdx.x, DFF / 64, last ? 0 : 2, 4);
            pg8::EpiBf16 E{YBUF, D, 0, nullptr, nullptr, YP, ML, (size_t)MC * D, 0u}; pg8::gemm_phase<pg8::EpiBf16, pg8::StaticOrder, true, true>(F.lds, g, S, E); WC_SLOT(35373, 42112, 64); }
        SEAM(pb + 10);
        if (IN(pb + 11)) { REFRESH();
            if (!last) { NormP P{xs, cs, xs, cs, YBUF, ABUF, modl, gl, modl + 3 * NMOD * D, gl + 6 * D, YP, 8, 5, 0, 0, 1, 1}; norm_phase<true, true, XS16, XS16>(F, P, true); }
            else { NormP P{xs, cs, args.out, cs, YBUF, nullptr, modl, gl, nullptr, nullptr, YP, 8, 5, 0, 0, 0, 1}; norm_phase<true, false, XS16, false>(F, P, false); } }
        SEAM(pb + 11);
    }
#if defined(STOP_PH)
#ifndef DUMP_F32
#define DUMP_F32 0
#endif
    if (lo == 1000) {
        const bf16* B = (const bf16*)(ws + (size_t)DUMP_WS);
        for (size_t i = (size_t)blockIdx.x * NTHR + threadIdx.x; i < (size_t)ML * D; i += (size_t)gridDim.x * NTHR) args.out[i] = DUMP_F32 ? ((const float*)B)[i] : bflo((unsigned)B[i]);
    }
#endif
#undef IN
#undef SEAM
}

extern "C" void kernel_launch(void* const* d_in, const int* in_sizes, int n_in, void* d_out, int out_size, void* d_ws, size_t ws_size, hipStream_t stream) {
    static int grid = 0;
    if (grid == 0) {
        if (n_in != 16 || in_sizes[0] != ML * D || out_size != ML * D || ws_size < WS_END) { fprintf(stderr, "kernel_launch: unexpected shapes: n_in %d in0 %d out %d ws %zu (need %zu); nothing launched\n", n_in, n_in > 0 ? in_sizes[0] : -1, out_size, ws_size, (size_t)WS_END); grid = -1; return; }
        int dev = 0, cus = 0, per_cu = 0;
        if (hipGetDevice(&dev) != hipSuccess || hipDeviceGetAttribute(&cus, hipDeviceAttributeMultiprocessorCount, dev) != hipSuccess) { grid = -1; return; }
        if (hipFuncSetAttribute((const void*)fwd, hipFuncAttributeMaxDynamicSharedMemorySize, LDS_BYTES) != hipSuccess) { fprintf(stderr, "kernel_launch: hipFuncSetAttribute failed\n"); grid = -1; return; }
        if (hipOccupancyMaxActiveBlocksPerMultiprocessor(&per_cu, (const void*)fwd, NTHR, LDS_BYTES) != hipSuccess || per_cu < 1) fprintf(stderr, "kernel_launch: occupancy query reports %d\n", per_cu);
        (void)hipGetLastError();
        grid = cus;
    }
    if (grid < 0) return;
    if (hipMemsetAsync((char*)d_ws, 0, ZERO_BYTES, stream) != hipSuccess) { fprintf(stderr, "kernel_launch: memset failed\n"); return; }
    Args a{};
    for (int i = 0; i < 16; ++i) a.in[i] = (const float*)d_in[i];
    a.out = (float*)d_out; a.ws = (unsigned char*)d_ws;
#if MK_ONE_LAUNCH
    a.ph_lo = 0; a.ph_hi = N_PHASES;
    hipLaunchKernelGGL(fwd, dim3(grid), dim3(NTHR), LDS_BYTES, stream, a);
#else
#if defined(STOP_PH)
    for (int p = 0; p < STOP_PH; ++p) { a.ph_lo = p; a.ph_hi = p + 1; hipLaunchKernelGGL(fwd, dim3(grid), dim3(NTHR), LDS_BYTES, stream, a); }
    a.ph_lo = 1000; a.ph_hi = 1001; hipLaunchKernelGGL(fwd, dim3(grid), dim3(NTHR), LDS_BYTES, stream, a);
#else
    for (int p = 0; p < N_PHASES; ++p) { a.ph_lo = p; a.ph_hi = p + 1; hipLaunchKernelGGL(fwd, dim3(grid), dim3(NTHR), LDS_BYTES, stream, a); }
#endif
#endif
    const hipError_t le = hipPeekAtLastError();
    if (le != hipSuccess) fprintf(stderr, "kernel_launch: launch failed: %s\n", hipGetErrorName(le));
}
```
